# Optimizing an MI355X kernel written in HIP

```python
import math
import jax, jax.numpy as jnp
from jax import lax
import numpy as np

D_MODEL = 2048
BATCH = 4
SEQ = 4096
DEPTH = 4

D_MIX = D_MODEL
W_GROUP = D_MIX // 4
ROPE_THETA = 500000.0
NORM_EPS = 1e-6
Q_BLOCK = 128

MLA_HEADS = 4
MLA_NOPE = 128
MLA_ROPE = 64
MLA_V = W_GROUP // MLA_HEADS
MLA_Q_LORA = 512
MLA_KV_LORA = 256

S5_GROUP = 16
S5_GROUPS = W_GROUP // S5_GROUP
S5_STATE = 64
S5_DT_MIN = 0.001
S5_DT_MAX = 0.1

RWKV_HEAD = 64
RWKV_HEADS = W_GROUP // RWKV_HEAD
RWKV_DECAY_LORA = 64
RWKV_ICL_LORA = 64
RWKV_GN_EPS = 64e-5

DIFF_HEADS = 4
DIFF_QK = W_GROUP // (2 * DIFF_HEADS)
DIFF_V = 2 * DIFF_QK
DIFF_ROT = DIFF_QK // 4
DIFF_SUBLN_EPS = 1e-5

N_RWKV = 3 * W_GROUP + RWKV_DECAY_LORA + RWKV_ICL_LORA
PROJ_SIZES = (MLA_Q_LORA, MLA_KV_LORA, MLA_ROPE,
              W_GROUP,
              N_RWKV,
              W_GROUP, W_GROUP, W_GROUP,
              D_MIX)
RWKV_SIZES = (W_GROUP, W_GROUP, W_GROUP, RWKV_DECAY_LORA, RWKV_ICL_LORA)
N_IN = sum(PROJ_SIZES)

kernel_name = 'hymba_style_mla_s5_rwkv7_diffattn'


def _split_points(sizes):
    return [int(v) for v in np.cumsum(sizes)[:-1]]


def rms_norm(x, g, eps=NORM_EPS):
    xf = x.astype(jnp.float32)
    y = xf * lax.rsqrt(jnp.mean(xf * xf, axis=-1, keepdims=True) + eps)
    return (y * g.astype(jnp.float32)).astype(x.dtype)


def rope_tables(positions, rot):
    inv = ROPE_THETA ** (-jnp.arange(0, rot, 2, dtype=jnp.float32) / rot)
    ang = positions.astype(jnp.float32)[..., None] * inv
    return jnp.cos(ang)[:, :, None, :], jnp.sin(ang)[:, :, None, :]


def apply_rope(x, cos, sin):
    rot = 2 * cos.shape[-1]
    xr = x[..., :rot].astype(jnp.float32)
    x1, x2 = xr[..., :rot // 2], xr[..., rot // 2:]
    y = jnp.concatenate([x1 * cos - x2 * sin, x2 * cos + x1 * sin], axis=-1).astype(x.dtype)
    return jnp.concatenate([y, x[..., rot:]], axis=-1)


def _to_blocks(t):
    b, s = t.shape[:2]
    t = t.reshape((b, s // Q_BLOCK, Q_BLOCK) + t.shape[2:])
    return jnp.moveaxis(t, 1, 0)


def _from_blocks(t):
    t = jnp.moveaxis(t, 0, 1)
    return t.reshape((t.shape[0], -1) + t.shape[3:])


def _causal_mask(blk, seq):
    qpos = blk * Q_BLOCK + jnp.arange(Q_BLOCK)
    return qpos[:, None] >= jnp.arange(seq)[None, :]


def causal_attention(q, k, v, scale):
    seq = k.shape[1]
    nb = q.shape[1] // Q_BLOCK

    def one_block(args):
        qb, blk = args
        s = jnp.einsum('bqhd,bkhd->bhqk', qb, k, preferred_element_type=jnp.float32) * scale
        s = jnp.where(_causal_mask(blk, seq), s, -jnp.inf)
        p = jax.nn.softmax(s, axis=-1)
        return jnp.einsum('bhqk,bkhd->bqhd', p.astype(v.dtype), v)

    return _from_blocks(lax.map(one_block, (_to_blocks(q), jnp.arange(nb))))


def causal_diff_attention(q, k, v, lam, scale):
    seq = k.shape[1]
    nb = q.shape[1] // Q_BLOCK

    def one_block(args):
        qb, blk = args
        s = jnp.einsum('bqhmd,bkhmd->bhmqk', qb, k, preferred_element_type=jnp.float32) * scale
        s = jnp.where(_causal_mask(blk, seq), s, -jnp.inf)
        p = jax.nn.softmax(s, axis=-1)
        pd = p[:, :, 0] - lam * p[:, :, 1]
        return jnp.einsum('bhqk,bkhd->bqhd', pd.astype(v.dtype), v)

    return _from_blocks(lax.map(one_block, (_to_blocks(q), jnp.arange(nb))))


def mla_branch(c_q, c_kv, k_rope, q_norm_g, kv_norm_g, w_uq, w_ukv, cos, sin):
    b, s, _ = c_q.shape
    q = (rms_norm(c_q, q_norm_g) @ w_uq).reshape(b, s, MLA_HEADS, MLA_NOPE + MLA_ROPE)
    kv = (rms_norm(c_kv, kv_norm_g) @ w_ukv).reshape(b, s, MLA_HEADS, MLA_NOPE + MLA_V)
    q = jnp.concatenate([q[..., :MLA_NOPE], apply_rope(q[..., MLA_NOPE:], cos, sin)], axis=-1)
    k_pe = apply_rope(k_rope[:, :, None, :], cos, sin)
    k = jnp.concatenate([kv[..., :MLA_NOPE],
                         jnp.broadcast_to(k_pe, (b, s, MLA_HEADS, MLA_ROPE))], axis=-1)
    v = kv[..., MLA_NOPE:]
    o = causal_attention(q, k, v, (MLA_NOPE + MLA_ROPE) ** -0.5)
    return o.reshape(b, s, MLA_HEADS * MLA_V)


def s5_branch(u, a_re, a_im, log_dt, b_re, b_im, c_re, c_im, d, w_glu, b_glu):
    f32 = jnp.float32
    bsz, s, _ = u.shape
    uf = u.astype(f32)
    ug = uf.reshape(bsz, s, S5_GROUPS, S5_GROUP)
    lr = jnp.minimum(a_re.astype(f32), -1e-4)
    li = a_im.astype(f32)
    dt = jnp.exp(log_dt.astype(f32))[:, None]
    mag = jnp.exp(dt * lr)
    ab_re, ab_im = mag * jnp.cos(dt * li), mag * jnp.sin(dt * li)
    den = lr * lr + li * li
    nr, ni = ab_re - 1.0, ab_im
    f_re = (nr * lr + ni * li) / den
    f_im = (ni * lr - nr * li) / den
    br, bi = b_re.astype(f32), b_im.astype(f32)
    bb_re = f_re[..., None] * br - f_im[..., None] * bi
    bb_im = f_re[..., None] * bi + f_im[..., None] * br
    bu_re = jnp.einsum('bsgc,gpc->bsgp', ug, bb_re)
    bu_im = jnp.einsum('bsgc,gpc->bsgp', ug, bb_im)
    shape = bu_re.shape
    elems = (jnp.broadcast_to(ab_re, shape), jnp.broadcast_to(ab_im, shape), bu_re, bu_im)

    def combine(e1, e2):
        a1r, a1i, b1r, b1i = e1
        a2r, a2i, b2r, b2i = e2
        return (a2r * a1r - a2i * a1i, a2r * a1i + a2i * a1r,
                a2r * b1r - a2i * b1i + b2r, a2r * b1i + a2i * b1r + b2i)

    _, _, h_re, h_im = lax.associative_scan(combine, elems, axis=1)
    y = (jnp.einsum('bsgp,gcp->bsgc', h_re, c_re.astype(f32))
         - jnp.einsum('bsgp,gcp->bsgc', h_im, c_im.astype(f32)))
    y = y.reshape(bsz, s, W_GROUP) + d.astype(f32) * uf
    g = jax.nn.gelu(y)
    out = g * jax.nn.sigmoid(g @ w_glu.astype(f32) + b_glu.astype(f32))
    return out.astype(u.dtype)


def rwkv7_branch(z, mu, w0, w2, a0, a2, k_k, k_a, r_k, ln_g, ln_b):
    f32 = jnp.float32
    bsz, s, _ = z.shape
    z_prev = jnp.pad(z, ((0, 0), (1, 0), (0, 0)))[:, :-1]
    z = z + (z_prev - z) * mu
    r, k, v, w_lo, a_lo = jnp.split(z, _split_points(RWKV_SIZES), axis=-1)
    w_log = -jax.nn.softplus(-(w0 + jnp.tanh(w_lo) @ w2)) - 0.5
    decay = jnp.exp(-jnp.exp(w_log.astype(f32)))
    a = jax.nn.sigmoid(a0 + a_lo @ a2)

    def heads(t):
        return t.reshape(bsz, s, RWKV_HEADS, RWKV_HEAD).astype(f32)

    kk = heads(k * k_k)
    kk = kk / jnp.maximum(jnp.sqrt(jnp.sum(kk * kk, axis=-1, keepdims=True)), 1e-12)
    k = k * (1.0 + (a - 1.0) * k_a)
    r_h, k_h, v_h, w_h, a_h = heads(r), heads(k), heads(v), heads(decay), heads(a)
    seq_in = tuple(jnp.moveaxis(t, 1, 0) for t in (r_h, w_h, k_h, v_h, -kk, kk * a_h))

    def step(state, inp):
        r_t, w_t, k_t, v_t, a_t, b_t = inp
        sa = jnp.einsum('bhvk,bhk->bhv', state, a_t)
        state = (state * w_t[:, :, None, :] + sa[..., None] * b_t[:, :, None, :]
                 + v_t[..., None] * k_t[:, :, None, :])
        return state, jnp.einsum('bhvk,bhk->bhv', state, r_t)

    state0 = jnp.zeros((bsz, RWKV_HEADS, RWKV_HEAD, RWKV_HEAD), f32)
    _, o = lax.scan(step, state0, seq_in)
    o = jnp.moveaxis(o, 0, 1)
    mean = jnp.mean(o, axis=-1, keepdims=True)
    var = jnp.mean(jnp.square(o - mean), axis=-1, keepdims=True)
    o = ((o - mean) * lax.rsqrt(var + RWKV_GN_EPS)).reshape(bsz, s, W_GROUP)
    o = o * ln_g.astype(f32) + ln_b.astype(f32)
    bonus = jnp.sum(r_h * k_h * r_k.astype(f32), axis=-1, keepdims=True) * v_h
    return (o + bonus.reshape(bsz, s, W_GROUP)).astype(z.dtype)


def diff_branch(q, k, v, lq1, lk1, lq2, lk2, subln_g, lam_init, cos, sin):
    f32 = jnp.float32
    bsz, s, _ = q.shape
    q = apply_rope(q.reshape(bsz, s, 2 * DIFF_HEADS, DIFF_QK), cos, sin)
    k = apply_rope(k.reshape(bsz, s, 2 * DIFF_HEADS, DIFF_QK), cos, sin)
    q = q.reshape(bsz, s, DIFF_HEADS, 2, DIFF_QK)
    k = k.reshape(bsz, s, DIFF_HEADS, 2, DIFF_QK)
    v = v.reshape(bsz, s, DIFF_HEADS, DIFF_V)
    lam = (jnp.exp(jnp.sum(lq1.astype(f32) * lk1.astype(f32)))
           - jnp.exp(jnp.sum(lq2.astype(f32) * lk2.astype(f32))) + lam_init)
    o = causal_diff_attention(q, k, v, lam, DIFF_QK ** -0.5)
    o = rms_norm(o, subln_g, eps=DIFF_SUBLN_EPS) * (1.0 - lam_init)
    return o.reshape(bsz, s, W_GROUP)


def setup_inputs(seed: int = 0) -> dict:
    key = jax.random.key(seed)
    ks = jax.random.split(key, 40)
    L = DEPTH

    def nrm(k, shape, scale):
        return jax.random.normal(k, shape, jnp.float32) * scale

    x = jax.random.normal(ks[0], (BATCH, SEQ, D_MODEL), jnp.float32)
    offset = jax.random.randint(ks[1], (BATCH, 1), 0, 1024, dtype=jnp.int32)
    positions = offset + jnp.arange(SEQ, dtype=jnp.int32)[None, :]
    s5_im0 = math.pi * jnp.arange(S5_STATE, dtype=jnp.float32)
    return {
        'x': x,
        'positions': positions,
        'norm_g': 1.0 + nrm(ks[2], (L, D_MODEL), 0.02),
        'w_in': nrm(ks[3], (L, D_MODEL, N_IN), D_MODEL ** -0.5),
        'w_out': nrm(ks[4], (L, D_MIX, D_MODEL), D_MIX ** -0.5),
        'mla_q_norm_g': 1.0 + nrm(ks[5], (L, MLA_Q_LORA), 0.02),
        'mla_kv_norm_g': 1.0 + nrm(ks[6], (L, MLA_KV_LORA), 0.02),
        'mla_w_uq': nrm(ks[7], (L, MLA_Q_LORA, MLA_HEADS * (MLA_NOPE + MLA_ROPE)), MLA_Q_LORA ** -0.5),
        'mla_w_ukv': nrm(ks[8], (L, MLA_KV_LORA, MLA_HEADS * (MLA_NOPE + MLA_V)), MLA_KV_LORA ** -0.5),
        's5_a_re': -0.5 + nrm(ks[9], (L, S5_GROUPS, S5_STATE), 0.01),
        's5_a_im': s5_im0 + nrm(ks[10], (L, S5_GROUPS, S5_STATE), 0.01),
        's5_log_dt': jax.random.uniform(ks[11], (L, S5_GROUPS), jnp.float32,
                                        math.log(S5_DT_MIN), math.log(S5_DT_MAX)),
        's5_b_re': nrm(ks[12], (L, S5_GROUPS, S5_STATE, S5_GROUP), (2 * S5_GROUP) ** -0.5),
        's5_b_im': nrm(ks[13], (L, S5_GROUPS, S5_STATE, S5_GROUP), (2 * S5_GROUP) ** -0.5),
        's5_c_re': nrm(ks[14], (L, S5_GROUPS, S5_GROUP, S5_STATE), (2 * S5_STATE) ** -0.5),
        's5_c_im': nrm(ks[15], (L, S5_GROUPS, S5_GROUP, S5_STATE), (2 * S5_STATE) ** -0.5),
        's5_d': nrm(ks[16], (L, W_GROUP), 1.0),
        's5_w_glu': nrm(ks[17], (L, W_GROUP, W_GROUP), W_GROUP ** -0.5),
        's5_b_glu': nrm(ks[18], (L, W_GROUP), 0.01),
        'rwkv_mu': jax.random.uniform(ks[19], (L, N_RWKV), jnp.float32),
        'rwkv_w0': jnp.linspace(-6.0, -1.0, W_GROUP, dtype=jnp.float32)[None, :] + nrm(ks[20], (L, W_GROUP), 0.1),
        'rwkv_w2': nrm(ks[21], (L, RWKV_DECAY_LORA, W_GROUP), 0.5 * RWKV_DECAY_LORA ** -0.5),
        'rwkv_a0': nrm(ks[22], (L, W_GROUP), 0.1),
        'rwkv_a2': nrm(ks[23], (L, RWKV_ICL_LORA, W_GROUP), 0.5 * RWKV_ICL_LORA ** -0.5),
        'rwkv_k_k': 0.85 + nrm(ks[24], (L, W_GROUP), 0.05),
        'rwkv_k_a': 1.0 + nrm(ks[25], (L, W_GROUP), 0.05),
        'rwkv_r_k': nrm(ks[26], (L, RWKV_HEADS, RWKV_HEAD), 0.1),
        'rwkv_ln_g': 1.0 + nrm(ks[27], (L, W_GROUP), 0.02),
        'rwkv_ln_b': nrm(ks[28], (L, W_GROUP), 0.01),
        'diff_lq1': nrm(ks[29], (L, DIFF_QK), 0.1),
        'diff_lk1': nrm(ks[30], (L, DIFF_QK), 0.1),
        'diff_lq2': nrm(ks[31], (L, DIFF_QK), 0.1),
        'diff_lk2': nrm(ks[32], (L, DIFF_QK), 0.1),
        'diff_subln_g': 1.0 + nrm(ks[33], (L, DIFF_V), 0.02),
        'final_norm_g': 1.0 + nrm(ks[34], (D_MODEL,), 0.02),
    }


def reference(x, positions, norm_g, w_in, w_out, mla_q_norm_g, mla_kv_norm_g, mla_w_uq, mla_w_ukv,
              s5_a_re, s5_a_im, s5_log_dt, s5_b_re, s5_b_im, s5_c_re, s5_c_im, s5_d, s5_w_glu, s5_b_glu,
              rwkv_mu, rwkv_w0, rwkv_w2, rwkv_a0, rwkv_a2, rwkv_k_k, rwkv_k_a, rwkv_r_k, rwkv_ln_g, rwkv_ln_b,
              diff_lq1, diff_lk1, diff_lq2, diff_lk2, diff_subln_g, final_norm_g):
    cos_a, sin_a = rope_tables(positions, MLA_ROPE)
    cos_d, sin_d = rope_tables(positions, DIFF_ROT)
    points = _split_points(PROJ_SIZES)
    for l in range(DEPTH):
        h = rms_norm(x, norm_g[l])
        proj = h @ w_in[l]
        c_q, c_kv, k_rope, u_s5, z_rwkv, q_d, k_d, v_d, gate = jnp.split(proj, points, axis=-1)
        y_a = mla_branch(c_q, c_kv, k_rope, mla_q_norm_g[l], mla_kv_norm_g[l],
                         mla_w_uq[l], mla_w_ukv[l], cos_a, sin_a)
        y_b = s5_branch(u_s5, s5_a_re[l], s5_a_im[l], s5_log_dt[l], s5_b_re[l], s5_b_im[l],
                        s5_c_re[l], s5_c_im[l], s5_d[l], s5_w_glu[l], s5_b_glu[l])
        y_c = rwkv7_branch(z_rwkv, rwkv_mu[l], rwkv_w0[l], rwkv_w2[l], rwkv_a0[l], rwkv_a2[l],
                           rwkv_k_k[l], rwkv_k_a[l], rwkv_r_k[l], rwkv_ln_g[l], rwkv_ln_b[l])
        lam_init = 0.8 - 0.6 * math.exp(-0.3 * l)
        y_d = diff_branch(q_d, k_d, v_d, diff_lq1[l], diff_lk1[l], diff_lq2[l], diff_lk2[l],
                          diff_subln_g[l], lam_init, cos_d, sin_d)
        mixed = jnp.concatenate([y_a, y_b, y_c, y_d], axis=-1) * jax.nn.silu(gate)
        x = x + (mixed @ w_out[l]).astype(x.dtype)
    return rms_norm(x, final_norm_g)
```

```cpp
#include <hip/hip_runtime.h>
#include <cstdio>
#include <cstdint>

namespace pg8 {
#define PG8_LAS __attribute__((address_space(3)))
typedef unsigned short bf16_t;
typedef short bf16x8 __attribute__((ext_vector_type(8)));
typedef float f32x4 __attribute__((ext_vector_type(4)));
typedef unsigned u32x4 __attribute__((ext_vector_type(4)));
constexpr int BM = 256, BK = 64, HALF = 128, HTB = HALF * BK * 2, STAGE_BYTES = 8 * HTB, NXCD = 8, WGM = 8;

__host__ __device__ __forceinline__ int lds_byte(int r, int c) { const int st = (r >> 4) * 2 + (c >> 5), rr = r & 15, cc = c & 31, ob = rr * 64 + cc * 2; return st * 1024 + (ob ^ (((ob >> 9) & 1) << 5)); }
__host__ __device__ __forceinline__ void stage_rc(int b, int& R, int& C) { const int st = b / 1024, sb = b % 1024, swz = sb ^ (((sb >> 9) & 1) << 5); R = (st >> 1) * 16 + swz / 64; C = (st & 1) * 32 + (swz % 64) / 2; }
__host__ __device__ __forceinline__ int perm32(int rho) { const int n = rho >> 4, i = rho & 15; return 8 * (i >> 2) + 4 * n + (i & 3); }

struct Unit { int pm, pn; };
struct Gemm { const bf16_t* A; const bf16_t* Bt; int M, N, K, lda, ldb; };

struct StaticOrder {
    int nM, nN, nwg, G, c;
    __host__ __device__ void init(int M, int N, int G_, int c_) { nM = M / BM; nN = N / BM; nwg = nM * nN; G = G_; c = c_; }
    __host__ __device__ bool next(int i, Unit& u) const {
        const long L = (long)i * G + c; if (L >= nwg) return false;
        int wgid = (int)L; { const int q = nwg / NXCD, r = nwg % NXCD, xcd = wgid % NXCD, off = wgid / NXCD; wgid = (xcd < r ? xcd * (q + 1) : r * (q + 1) + (xcd - r) * q) + off; }
        const int nig = WGM * nN, gid = wgid / nig, fm = gid * WGM, gsz = (nM - fm) < WGM ? (nM - fm) : WGM;
        u.pm = fm + ((wgid % nig) % gsz); u.pn = (wgid % nig) / gsz; return true;
    }
};
typedef __bf16 bf16n2 __attribute__((ext_vector_type(2)));
typedef float f32n2 __attribute__((ext_vector_type(2)));
__device__ __forceinline__ unsigned cvt_pk_bf16(float lo, float hi) { const bf16n2 r = __builtin_convertvector((f32n2){lo, hi}, bf16n2); return __builtin_bit_cast(unsigned, r); }

template <class Epi, class Sched, int PV = 0>
__device__ __forceinline__ void gemm_phase(PG8_LAS unsigned char* lds, const Gemm g, const Sched& S, const Epi& E, const int tid) {
    const int wid = __builtin_amdgcn_readfirstlane(tid >> 6), lane = tid & 63, wr = wid >> 2, wc = wid & 3, fr = lane & 15, fq = lane >> 4;
    const int K = g.K, nt = K / BK;
    unsigned voffA[2], voffB[2];
#pragma unroll
    for (int i = 0; i < 2; ++i) { int R, C; stage_rc(tid * 16 + i * 8192, R, C); const int Rb = Epi::PERM ? ((R & ~31) + perm32(R & 31)) : R;
        voffA[i] = (unsigned)(R * g.lda + C) * 2u; voffB[i] = (unsigned)(Rb * g.ldb + C) * 2u; }
    const size_t kstep = (PV == 1) ? (size_t)0 : (size_t)(BK * 2);
    const size_t hstepA = (size_t)HALF * g.lda * 2, hstepB = (size_t)HALF * g.ldb * 2;
    const size_t tstepA = 2 * hstepA, tstepB = 2 * hstepB;
    const unsigned ldsw = (unsigned)wid * 1024u;
    const int aoff = lds_byte(wr * 64 + fr, fq * 8), boff = lds_byte(wc * 32 + fr, fq * 8);
#define PG8_SA(b, h) (((b) * 2 + (h)) * HTB)
#define PG8_SB(b, h) ((4 + (b) * 2 + (h)) * HTB)
#define PG8_STAGE(bufoff, gbase, voff) do { _Pragma("unroll") for (int _i = 0; _i < 2; ++_i) \
        __builtin_amdgcn_global_load_lds((const unsigned*)((const char*)(gbase) + (voff)[_i]), (PG8_LAS unsigned*)(lds + (bufoff) + ldsw + _i * 8192), 16, 0, 0); } while (0)
#define PG8_LDA(dst, b, h) do { _Pragma("unroll") for (int m = 0; m < 4; ++m) _Pragma("unroll") for (int k = 0; k < 2; ++k) dst[m][k] = *(const PG8_LAS bf16x8*)(lds + PG8_SA(b, h) + aoff + m * 2048 + k * 1024); } while (0)
#define PG8_LDB(dst, b, h) do { _Pragma("unroll") for (int n = 0; n < 2; ++n) _Pragma("unroll") for (int k = 0; k < 2; ++k) dst[n][k] = *(const PG8_LAS bf16x8*)(lds + PG8_SB(b, h) + boff + n * 2048 + k * 1024); } while (0)
#define PG8_MMA(ai, bj, At, Bt) do { __builtin_amdgcn_s_setprio(1); _Pragma("unroll") for (int m = 0; m < 4; ++m) _Pragma("unroll") for (int n = 0; n < 2; ++n) _Pragma("unroll") for (int k = 0; k < 2; ++k) \
        acc[ai][bj][m][n] = __builtin_amdgcn_mfma_f32_16x16x32_bf16(Bt[n][k], At[m][k], acc[ai][bj][m][n], 0, 0, 0); __builtin_amdgcn_s_setprio(0); } while (0)
#define PG8_WAIT_V(n) asm volatile("s_waitcnt vmcnt(" #n ")" ::: "memory")
#define PG8_WAIT_L(n) asm volatile("s_waitcnt lgkmcnt(" #n ")" ::: "memory")
#define PG8_BAR __builtin_amdgcn_s_barrier()
#define PG8_SCHED __builtin_amdgcn_sched_barrier(0)
    Unit cur, nxt; int ui = 0;
    if (!S.next(0, cur)) return;
    f32x4 acc[2][2][4][2];
#pragma unroll
    for (int a = 0; a < 2; ++a)
#pragma unroll
        for (int b = 0; b < 2; ++b)
#pragma unroll
            for (int m = 0; m < 4; ++m)
#pragma unroll
                for (int n = 0; n < 2; ++n) acc[a][b][m][n] = (f32x4){0.f, 0.f, 0.f, 0.f};
    bf16x8 At[4][2], B0[2][2], B1[2][2];
    const char* cA = (const char*)g.A + (size_t)cur.pm * tstepA; const char* cB = (const char*)g.Bt + (size_t)cur.pn * tstepB;
    PG8_STAGE(PG8_SB(0, 0), cB, voffB); PG8_STAGE(PG8_SA(0, 0), cA, voffA); PG8_STAGE(PG8_SB(0, 1), cB + hstepB, voffB); PG8_STAGE(PG8_SA(0, 1), cA + hstepA, voffA);
    if (wr == 1) PG8_BAR;
    PG8_WAIT_V(4); PG8_BAR;
    PG8_STAGE(PG8_SB(1, 0), cB + kstep, voffB); PG8_STAGE(PG8_SA(1, 0), cA + kstep, voffA); PG8_STAGE(PG8_SB(1, 1), cB + hstepB + kstep, voffB);
    PG8_WAIT_V(6); PG8_BAR;
    for (;;) {
        const bool has_next = S.next(ui + 1, nxt);
        const char* nA = has_next ? (const char*)g.A + (size_t)nxt.pm * tstepA : cA; const char* nB = has_next ? (const char*)g.Bt + (size_t)nxt.pn * tstepB : cB;
        for (int t = 0; t < nt; t += 2) {
            const bool last = (t == nt - 2);
            const char* a1 = cA + (size_t)(t + 1) * kstep;
            const char* a2 = last ? nA : cA + (size_t)(t + 2) * kstep; const char* b2 = last ? nB : cB + (size_t)(t + 2) * kstep;
            const char* a3 = a2 + kstep; const char* b3 = b2 + kstep;
            PG8_LDB(B0, 0, 0); PG8_SCHED; PG8_LDA(At, 0, 0); PG8_STAGE(PG8_SA(1, 1), a1 + hstepA, voffA);
            PG8_WAIT_L(8); PG8_BAR; PG8_WAIT_L(0); PG8_MMA(0, 0, At, B0); PG8_BAR; PG8_SCHED;
            PG8_LDB(B1, 0, 1); PG8_STAGE(PG8_SB(0, 0), b2, voffB);
            PG8_BAR; PG8_WAIT_L(0); PG8_MMA(0, 1, At, B1); PG8_BAR;
            PG8_LDA(At, 0, 1); PG8_STAGE(PG8_SA(0, 0), a2, voffA);
            PG8_BAR; PG8_WAIT_L(0); PG8_MMA(1, 0, At, B0); PG8_BAR; PG8_SCHED;
            PG8_STAGE(PG8_SB(0, 1), b2 + hstepB, voffB);
            PG8_WAIT_V(6); PG8_BAR; PG8_MMA(1, 1, At, B1); PG8_BAR;
            PG8_LDB(B0, 1, 0); PG8_SCHED; PG8_LDA(At, 1, 0); PG8_STAGE(PG8_SA(0, 1), a2 + hstepA, voffA);
            PG8_WAIT_L(8); PG8_BAR; PG8_WAIT_L(0); PG8_MMA(0, 0, At, B0); PG8_BAR; PG8_SCHED;
            PG8_LDB(B1, 1, 1); PG8_STAGE(PG8_SB(1, 0), b3, voffB);
            PG8_BAR; PG8_WAIT_L(0); PG8_MMA(0, 1, At, B1); PG8_BAR;
            PG8_LDA(At, 1, 1); PG8_STAGE(PG8_SA(1, 0), a3, voffA);
            PG8_BAR; PG8_WAIT_L(0); PG8_MMA(1, 0, At, B0); PG8_BAR; PG8_SCHED;
            PG8_STAGE(PG8_SB(1, 1), b3 + hstepB, voffB);
            PG8_WAIT_V(6); PG8_BAR; PG8_MMA(1, 1, At, B1); PG8_BAR;
        }
        if constexpr (!Epi::AFTER_DRAIN && PV != 2) E(acc, cur, wr, wc, fr, fq);
        if constexpr (PV == 2) { _Pragma("unroll") for (int a_ = 0; a_ < 2; ++a_) _Pragma("unroll") for (int b_ = 0; b_ < 2; ++b_) _Pragma("unroll") for (int m_ = 0; m_ < 4; ++m_) _Pragma("unroll") for (int n_ = 0; n_ < 2; ++n_) asm volatile("" :: "v"(acc[a_][b_][m_][n_])); }
        if (!has_next) break;
#pragma unroll
        for (int a = 0; a < 2; ++a)
#pragma unroll
            for (int b = 0; b < 2; ++b)
#pragma unroll
                for (int m = 0; m < 4; ++m)
#pragma unroll
                    for (int n = 0; n < 2; ++n) acc[a][b][m][n] = (f32x4){0.f, 0.f, 0.f, 0.f};
        cur = nxt; cA = nA; cB = nB; ++ui;
    }
    PG8_WAIT_V(0);
    if (wr == 0) PG8_BAR;
    PG8_BAR;
    if constexpr (Epi::AFTER_DRAIN) E.after(acc, cur, wr, wc, fr, fq, lds);
#undef PG8_SA
#undef PG8_SB
#undef PG8_STAGE
#undef PG8_LDA
#undef PG8_LDB
#undef PG8_MMA
#undef PG8_WAIT_V
#undef PG8_WAIT_L
#undef PG8_BAR
#undef PG8_SCHED
}
}
#define XB_TMO      128
#define XB_XCNT(j)  (256  + 64 * (j))
#define XB_XSUB(j)  (1280 + 64 * (j))
#define XB_XGEN(j)  (2304 + 64 * (j))
#define XB_TOP      3328
#define XB_TOPGEN   3392
#define XCD_BAR_WORDS 3456
#define XB_SPIN_CAP (1u << 18)
#define LAS __attribute__((address_space(3)))

__device__ __forceinline__ unsigned xb_ld(unsigned* p)              { return __hip_atomic_load(p, __ATOMIC_RELAXED, __HIP_MEMORY_SCOPE_AGENT); }
__device__ __forceinline__ unsigned xb_add(unsigned* p, unsigned v) { return __hip_atomic_fetch_add(p, v, __ATOMIC_RELAXED, __HIP_MEMORY_SCOPE_AGENT); }
__device__ __forceinline__ unsigned xb_xcc_id() { return (unsigned)__builtin_amdgcn_s_getreg((3 << 11) | 20) & 0xFu; }
#define XB_SPIN(cond, bar) do { unsigned _sp = 0; while (cond) { __builtin_amdgcn_s_sleep(1); \
    if ((++_sp & 255u) == 0u) { if (xb_ld(&(bar)[XB_TMO])) break; if (_sp > XB_SPIN_CAP) { atomicAdd(&(bar)[XB_TMO], 1u); break; } } } } while (0)

__device__ __forceinline__ unsigned lane_id_now() { unsigned l_; asm volatile("v_mbcnt_lo_u32_b32 %0, -1, 0\n\tv_mbcnt_hi_u32_b32 %0, -1, %0" : "=v"(l_)); return l_; }
__device__ __forceinline__ bool xb_thread0(int wave_idx) { return wave_idx == 0 && lane_id_now() == 0u; }
struct XcdBarrier {
    unsigned* bar; unsigned x; int wave;
    volatile LAS unsigned* st;
};

__device__ __forceinline__ XcdBarrier xcd_barrier_post(unsigned* bar, volatile LAS unsigned* st, int wave_idx) {
    XcdBarrier b; b.bar = bar; b.x = xb_xcc_id(); b.st = st; b.wave = wave_idx;
    if (xb_thread0(wave_idx)) (void)xb_add(&bar[XB_XCNT(b.x)], 1u);
    return b;
}
__device__ __forceinline__ void xcd_barrier_complete(unsigned* bar, unsigned x, unsigned& nloc, unsigned& nx) {
    const unsigned G = gridDim.x * gridDim.y * gridDim.z;
    unsigned sum, cnt, mine, sp = 0u;
    for (;;) {
        sum = 0u; cnt = 0u; mine = 0u;
#pragma unroll
        for (unsigned j = 0; j < 16; ++j) { const unsigned c = xb_ld(&bar[XB_XCNT(j)]); sum += c; cnt += (c > 0u) ? 1u : 0u; mine = (j == x) ? c : mine; }
        if (sum == G) break;
        __builtin_amdgcn_s_sleep(1);
        if ((++sp & 255u) == 0u) { if (xb_ld(&bar[XB_TMO])) break; if (sp > XB_SPIN_CAP) { atomicAdd(&bar[XB_TMO], 1u); break; } }
    }
    nloc = mine > 0u ? mine : 1u; nx = cnt > 0u ? cnt : 1u;
}

__device__ __forceinline__ void xcd_barrier(const XcdBarrier& b) {
    asm volatile("s_waitcnt vmcnt(0)" ::: "memory");
    __syncthreads();
    if (xb_thread0(b.wave)) {
        unsigned* bar = b.bar;
        __builtin_amdgcn_s_waitcnt(0);
        unsigned nloc = b.st[0], nx = b.st[1];
        if (nloc == 0u) { xcd_barrier_complete(bar, b.x, nloc, nx); b.st[0] = nloc; b.st[1] = nx; }
        const unsigned old = xb_add(&bar[XB_XSUB(b.x)], 1u);
        const unsigned gen = old / nloc;
        if (old + 1u == (gen + 1u) * nloc) {
            __builtin_amdgcn_fence(__ATOMIC_RELEASE, "agent");
            asm volatile("s_waitcnt vmcnt(0)" ::: "memory");
            const unsigned og = xb_add(&bar[XB_TOP], 1u);
            const unsigned tg = og / nx;
            if (og + 1u == (tg + 1u) * nx) xb_add(&bar[XB_TOPGEN], 1u);
            else XB_SPIN(xb_ld(&bar[XB_TOPGEN]) == tg, bar);
            __builtin_amdgcn_fence(__ATOMIC_ACQUIRE, "agent");
            xb_add(&bar[XB_XGEN(b.x)], 1u);
            asm volatile("s_waitcnt vmcnt(0)" ::: "memory");
        } else {
            XB_SPIN(xb_ld(&bar[XB_XGEN(b.x)]) == gen, bar);
            __builtin_amdgcn_fence(__ATOMIC_ACQUIRE, "agent");
            asm volatile("s_waitcnt vmcnt(0)" ::: "memory");
        }
    }
    __syncthreads();
}
constexpr int NWAVES = 8, NTHR = 512;
constexpr int B_ = 4, S_ = 4096, D_ = 2048, L_ = 4, M_ = B_ * S_;
constexpr int NIN = 6592, LDP = 6656;
constexpr int C_CQ = 0, C_CKV = 512, C_KR = 768, C_US5 = 832, C_R = 1344, C_K = 1856, C_V = 2368, C_WLO = 2880, C_ALO = 2944,
              C_QD = 3008, C_KD = 3520, C_VD = 4032, C_GATE = 4544;
constexpr int NQ = 768, NKV = 1024;
constexpr float NORM_EPS = 1e-6f, THETA = 500000.f;
constexpr int S5_T = 64, S5_NCH = S_ / S5_T;

enum { I_X = 0, I_POS, I_NORMG, I_WIN, I_WOUT, I_QNG, I_KVNG, I_WUQ, I_WUKV, I_S5ARE, I_S5AIM, I_S5LDT, I_S5BRE, I_S5BIM, I_S5CRE, I_S5CIM, I_S5D, I_S5WGLU, I_S5BGLU,
       I_MU, I_W0, I_W2, I_A0, I_A2, I_KK, I_KA, I_RK, I_LNG, I_LNB, I_LQ1, I_LK1, I_LQ2, I_LK2, I_SUBG, I_FNG, N_INPUTS };

constexpr size_t MiB = 1u << 20;
constexpr size_t WS_CTL = 0, CTL_ZERO_BYTES = 1 * MiB;
constexpr size_t WS_WIN = 1 * MiB;
constexpr size_t WS_WOUT = 105 * MiB;
constexpr size_t WS_WUQ = 137 * MiB;
constexpr size_t WS_WUKV = 140 * MiB;
constexpr size_t WS_WGLU = 142 * MiB;
constexpr size_t WS_H = 144 * MiB;
constexpr size_t WS_MIXED = WS_H;
constexpr size_t WS_PROJ = 208 * MiB;
constexpr size_t WS_CQN = 416 * MiB;
constexpr size_t WS_SSP = 416 * MiB;
constexpr size_t WS_CKVN = 432 * MiB;
constexpr size_t WS_KR = 440 * MiB;
constexpr size_t WS_ROPEA = 442 * MiB;
constexpr size_t WS_ROPED = 446 * MiB;
constexpr size_t WS_QM = 448 * MiB;
constexpr size_t WS_KVM = 472 * MiB;
constexpr size_t WS_WLA = 504 * MiB;
constexpr size_t WS_GACT = 512 * MiB;
constexpr size_t WS_RW = 528 * MiB;
constexpr size_t WS_RWO = 624 * MiB;
constexpr size_t WS_LBT = 656 * MiB;
constexpr size_t WS_RWGT = 658 * MiB;
constexpr size_t WS_RWAW = 660 * MiB;
constexpr size_t WS_RWBT = 724 * MiB;
constexpr size_t WS_RWKT = 756 * MiB;
constexpr size_t WS_END = 788 * MiB;
constexpr size_t WS_ACAT = 788 * MiB;
constexpr size_t WS_S5KZ = 812 * MiB;
constexpr size_t WS_S5W1 = 818 * MiB;
constexpr size_t WS_END2 = 823 * MiB;

constexpr size_t RW_STRIDE = (size_t)M_ * 512;

constexpr int CW_BAR = 4096;
constexpr int CW_Q = 16384;

constexpr int LDS_BYTES = 147456;
constexpr int RSTD_OFF = 136192;
constexpr int MISC_OFF = 131072 + 320;

#define GAS __attribute__((address_space(1)))
typedef unsigned short bf16;
typedef unsigned v4u __attribute__((ext_vector_type(4)));
typedef unsigned v2u __attribute__((ext_vector_type(2)));
typedef float f32x4 __attribute__((ext_vector_type(4)));
typedef float f32x2 __attribute__((ext_vector_type(2)));
typedef float f32x16 __attribute__((ext_vector_type(16)));
typedef short bf16x8 __attribute__((ext_vector_type(8)));
typedef short s16x4 __attribute__((ext_vector_type(4)));

__device__ __forceinline__ unsigned pk2(float lo, float hi) { return pg8::cvt_pk_bf16(lo, hi); }
__device__ __forceinline__ float bflo(unsigned w) { return __uint_as_float(w << 16); }
__device__ __forceinline__ float bfhi(unsigned w) { return __uint_as_float(w & 0xffff0000u); }
__device__ __forceinline__ float bf1(bf16 b) { return __uint_as_float(((unsigned)b) << 16); }
__device__ __forceinline__ bf16 f2bf(float f) { return (bf16)(pk2(f, 0.f) & 0xffffu); }
__device__ __forceinline__ void unpack8(v4u w, float (&f)[8]) { f[0] = bflo(w.x); f[1] = bfhi(w.x); f[2] = bflo(w.y); f[3] = bfhi(w.y); f[4] = bflo(w.z); f[5] = bfhi(w.z); f[6] = bflo(w.w); f[7] = bfhi(w.w); }
__device__ __forceinline__ v4u pack8(const float (&f)[8]) { v4u w; w.x = pk2(f[0], f[1]); w.y = pk2(f[2], f[3]); w.z = pk2(f[4], f[5]); w.w = pk2(f[6], f[7]); return w; }
__device__ __forceinline__ float wave_sum(float v) {
#pragma unroll
    for (int o = 1; o < 64; o <<= 1) v += __shfl_xor(v, o);
    return v;
}
template <int CTRL> __device__ __forceinline__ float dppf(float v) { return __builtin_bit_cast(float, __builtin_amdgcn_update_dpp(0, __builtin_bit_cast(int, v), CTRL, 0xF, 0xF, true)); }
__device__ __forceinline__ float red8(float v) { v += dppf<0xB1>(v); v += dppf<0x4E>(v); v += dppf<0x141>(v); return v; }
__device__ __forceinline__ float red16(float v) { v += dppf<0xB1>(v); v += dppf<0x4E>(v); v += dppf<0x141>(v); v += dppf<0x140>(v); return v; }
__device__ __forceinline__ float readlane_f(float v, int l) { return __builtin_bit_cast(float, __builtin_amdgcn_readlane(__builtin_bit_cast(int, v), l)); }
__device__ __forceinline__ float wave_sum_fast(float v) {
    v = red16(v);
    return (readlane_f(v, 0) + readlane_f(v, 16)) + (readlane_f(v, 32) + readlane_f(v, 48));
}
__device__ __forceinline__ float tanh_fast(float x) { const float e = __expf(2.f * fminf(fmaxf(x, -15.f), 15.f)); return (e - 1.f) / (e + 1.f); }
__device__ __forceinline__ float pair_max(float v) { const auto rr = __builtin_amdgcn_permlane32_swap(__float_as_uint(v), __float_as_uint(v), false, false); return fmaxf(__uint_as_float(rr[0]), __uint_as_float(rr[1])); }
__device__ __forceinline__ float pair_sum(float v) { const auto rr = __builtin_amdgcn_permlane32_swap(__float_as_uint(v), __float_as_uint(v), false, false); return __uint_as_float(rr[0]) + __uint_as_float(rr[1]); }
__device__ __forceinline__ float shfl_up_l(float v, int d, int lane) {
    return __builtin_bit_cast(float, __builtin_amdgcn_ds_bpermute(((lane >= d ? lane - d : lane)) << 2, __builtin_bit_cast(int, v)));
}
__device__ __forceinline__ float exp_raw(float x) { return __builtin_amdgcn_exp2f(x * 1.4426950408889634f); }
__device__ __forceinline__ float log_raw(float x) { return __builtin_amdgcn_logf(x) * 0.6931471805599453f; }
__device__ __forceinline__ float rcp_raw(float x) { return __builtin_amdgcn_rcpf(x); }
__device__ __forceinline__ float sigmoidf_(float x) { return 1.f / (1.f + __expf(-x)); }
__device__ __forceinline__ float siluf_(float x) { return x / (1.f + __expf(-x)); }
__device__ __forceinline__ float gelu_fast(float y) { const float u = 0.7978845608028654f * (y + 0.044715f * y * y * y); return 0.5f * y * (1.f + tanh_fast(u)); }
__device__ __forceinline__ float gelu_tanh(float y) { const float u = 0.7978845608028654f * (y + 0.044715f * y * y * y); return 0.5f * y * (1.f + tanhf(u)); }

struct Args { const void* in[N_INPUTS]; float* out; unsigned char* ws; int ph_lo, ph_hi, rep, pad; };
typedef const __attribute__((address_space(4))) Args* AP;

struct TrItem { const float* W; bf16* WT; const float* gk; int K, N, item; };
__device__ __forceinline__ void tr_load(const TrItem& t, int lane, float (&v)[32], f32x4& ga, f32x4& gb) {
    const int nblk = t.N / 32, kb = t.item / nblk, nb = t.item % nblk, k0 = 64 * kb, n0 = 32 * nb;
    ga = (f32x4){1.f, 1.f, 1.f, 1.f}; gb = ga;
    if (t.gk) { ga = *(const f32x4*)(t.gk + k0 + 8 * (lane & 7)); gb = *(const f32x4*)(t.gk + k0 + 8 * (lane & 7) + 4); }
#pragma unroll
    for (int i = 0; i < 32; ++i) { const int kk = 2 * i + (lane >> 5); v[i] = t.W[(size_t)(k0 + kk) * t.N + n0 + (lane & 31)]; }
}
__device__ __forceinline__ void tr_store(const TrItem& t, float* scr, int lane, const float (&v)[32], const f32x4 ga, const f32x4 gb) {
    const int nblk = t.N / 32, kb = t.item / nblk, nb = t.item % nblk, k0 = 64 * kb, n0 = 32 * nb;
#pragma unroll
    for (int i = 0; i < 32; ++i) { const int kk = 2 * i + (lane >> 5); scr[kk * 33 + (lane & 31)] = v[i]; }
    __builtin_amdgcn_wave_barrier(); asm volatile("s_waitcnt lgkmcnt(0)" ::: "memory");
    const int c = lane & 7;
#pragma unroll
    for (int j = 0; j < 4; ++j) { const int n = (lane >> 3) + 8 * j; const float* s = scr + (8 * c) * 33 + n;
        v4u o; o.x = pk2(s[0 * 33] * ga.x, s[1 * 33] * ga.y); o.y = pk2(s[2 * 33] * ga.z, s[3 * 33] * ga.w); o.z = pk2(s[4 * 33] * gb.x, s[5 * 33] * gb.y); o.w = pk2(s[6 * 33] * gb.z, s[7 * 33] * gb.w);
        *(v4u*)(t.WT + (size_t)(n0 + n) * t.K + k0 + 8 * c) = o; }
    __builtin_amdgcn_wave_barrier(); asm volatile("s_waitcnt lgkmcnt(0)" ::: "memory");
}
__device__ __forceinline__ TrItem tr_decode(AP a, int it) {
    constexpr int I_IN = (D_ / 64) * (NIN / 32), I_OUT = (D_ / 64) * (D_ / 32), I_UQ = (512 / 64) * (NQ / 32), I_UKV = (256 / 64) * (NKV / 32), I_GLU = (512 / 64) * (512 / 32);
    constexpr int PER_L = I_IN + I_OUT + I_UQ + I_UKV + I_GLU;
    const int l = it / PER_L; int r = it % PER_L;
    if (r < I_IN) return TrItem{(const float*)a->in[I_WIN] + (size_t)l * D_ * NIN, (bf16*)(a->ws + WS_WIN) + (size_t)l * LDP * D_, (const float*)a->in[I_NORMG] + l * D_, D_, NIN, r}; r -= I_IN;
    if (r < I_OUT) return TrItem{(const float*)a->in[I_WOUT] + (size_t)l * D_ * D_, (bf16*)(a->ws + WS_WOUT) + (size_t)l * D_ * D_, nullptr, D_, D_, r}; r -= I_OUT;
    if (r < I_UQ) return TrItem{(const float*)a->in[I_WUQ] + (size_t)l * 512 * NQ, (bf16*)(a->ws + WS_WUQ) + (size_t)l * NQ * 512, nullptr, 512, NQ, r}; r -= I_UQ;
    if (r < I_UKV) return TrItem{(const float*)a->in[I_WUKV] + (size_t)l * 256 * NKV, (bf16*)(a->ws + WS_WUKV) + (size_t)l * NKV * 256, nullptr, 256, NKV, r}; r -= I_UKV;
    return TrItem{(const float*)a->in[I_S5WGLU] + (size_t)l * 512 * 512, (bf16*)(a->ws + WS_WGLU) + (size_t)l * 512 * 512, nullptr, 512, 512, r};
}
__device__ __forceinline__ void phase_convert(AP a, unsigned char* lds, int gw, int NGW, int wave, int lane) {
    float* scr = (float*)(lds + wave * 16384);
    constexpr int I_IN = (D_ / 64) * (NIN / 32), I_OUT = (D_ / 64) * (D_ / 32), I_UQ = (512 / 64) * (NQ / 32), I_UKV = (256 / 64) * (NKV / 32), I_GLU = (512 / 64) * (512 / 32);
    constexpr int TOTAL = L_ * (I_IN + I_OUT + I_UQ + I_UKV + I_GLU);
    {   TrItem cur{}; float v[32]; f32x4 ga = {1.f, 1.f, 1.f, 1.f}, gb = ga;
        if (gw < TOTAL) { cur = tr_decode(a, gw); tr_load(cur, lane, v, ga, gb); }
        for (int it = gw; it < TOTAL; it += NGW) {
            TrItem nx{}; float nv[32]; f32x4 nga = ga, ngb = gb; const bool more = it + NGW < TOTAL;
            if (more) { nx = tr_decode(a, it + NGW); tr_load(nx, lane, nv, nga, ngb); }
            tr_store(cur, scr, lane, v, ga, gb);
            if (more) { cur = nx; ga = nga; gb = ngb;
#pragma unroll
                for (int i = 0; i < 32; ++i) v[i] = nv[i]; }
        }
    }
    for (int i = gw * 64 + lane; i < L_ * 16384; i += NGW * 64) { const int l = i / 16384, o = i % 16384;
        unsigned z = 0u; asm volatile("" : "+v"(z));
        *(v4u*)((bf16*)(a->ws + WS_WIN) + ((size_t)l * LDP + NIN) * D_ + (size_t)o * 8) = (v4u){z, z, z, z}; }
    for (int i = gw * 64 + lane; i < L_ * 1024 * 32; i += NGW * 64) { const int l = i >> 15, n = (i >> 5) & 1023, k0 = (i & 31) * 8; float x[8];
        const float* src = (n < 512) ? (const float*)a->in[I_W2] + (size_t)l * 64 * 512 + n : (const float*)a->in[I_A2] + (size_t)l * 64 * 512 + (n - 512);
        const int kb = (n < 512) ? k0 : k0 - 64;
#pragma unroll
        for (int j = 0; j < 8; ++j) x[j] = (kb >= 0 && kb < 64) ? src[(size_t)(kb + j) * 512] : 0.f;
        *(v4u*)((bf16*)(a->ws + WS_LBT) + ((size_t)l * 1024 + n) * 256 + k0) = pack8(x); }
    {   const float* src = (const float*)a->in[I_X]; bf16* xb = (bf16*)a->out; float* ss = (float*)(a->ws + WS_SSP);
        f32x4 nv[8];
        if (gw < M_) { const f32x4* xr = (const f32x4*)(src + (size_t)gw * D_) + lane;
#pragma unroll
            for (int j = 0; j < 8; ++j) nv[j] = xr[64 * j]; }
        for (int m = gw; m < M_; m += NGW) {
            v2u* o = (v2u*)(xb + (size_t)m * D_) + lane;
            f32x4 v[8]; float sq = 0.f;
#pragma unroll
            for (int j = 0; j < 8; ++j) { v[j] = nv[j]; sq += (v[j].x * v[j].x + v[j].y * v[j].y) + (v[j].z * v[j].z + v[j].w * v[j].w); }
            if (m + NGW < M_) { const f32x4* xr = (const f32x4*)(src + (size_t)(m + NGW) * D_) + lane;
#pragma unroll
                for (int j = 0; j < 8; ++j) nv[j] = xr[64 * j]; }
#pragma unroll
            for (int j = 0; j < 8; ++j) { v2u w; w.x = pk2(v[j].x, v[j].y); w.y = pk2(v[j].z, v[j].w); o[64 * j] = w; }
            sq = wave_sum_fast(sq);
            if (lane < 32) ss[(size_t)m * 32 + lane] = (lane == 0) ? sq : 0.f;
        }
    }
    const int* pos = (const int*)a->in[I_POS];
    float* cA = (float*)(a->ws + WS_ROPEA); float* sA = cA + (size_t)M_ * 32; float* cD = (float*)(a->ws + WS_ROPED); float* sD = cD + (size_t)M_ * 8;
    for (int m = gw; m < M_; m += NGW) {
        const float p = (float)pos[m];
        if (lane < 32) { const float inv = powf(THETA, -(float)(2 * lane) / 64.f); float sn, cs; sincosf(p * inv, &sn, &cs); cA[(size_t)m * 32 + lane] = cs; sA[(size_t)m * 32 + lane] = sn; }
        else if (lane < 40) { const int j = lane - 32; const float inv = powf(THETA, -(float)(2 * j) / 16.f); float sn, cs; sincosf(p * inv, &sn, &cs); cD[(size_t)m * 8 + j] = cs; sD[(size_t)m * 8 + j] = sn; }
    }
}

template <bool OUT_F32>
__device__ __forceinline__ void phase_rmsnorm(const float* src, const float* g, void* dst, int gw, int NGW, int lane) {
    f32x4 gv[8];
#pragma unroll
    for (int j = 0; j < 8; ++j) gv[j] = ((const f32x4*)g)[64 * j + lane];
    f32x4 nv[8];
    if (gw < M_) { const f32x4* xr = (const f32x4*)(src + (size_t)gw * D_) + lane;
#pragma unroll
        for (int j = 0; j < 8; ++j) nv[j] = xr[64 * j]; }
    for (int m = gw; m < M_; m += NGW) {
        f32x4 v[8]; float s = 0.f;
#pragma unroll
        for (int j = 0; j < 8; ++j) { v[j] = nv[j]; s += (v[j].x * v[j].x + v[j].y * v[j].y) + (v[j].z * v[j].z + v[j].w * v[j].w); }
        if (m + NGW < M_) { const f32x4* xr = (const f32x4*)(src + (size_t)(m + NGW) * D_) + lane;
#pragma unroll
            for (int j = 0; j < 8; ++j) nv[j] = xr[64 * j]; }
        const float rstd = 1.f / sqrtf(wave_sum_fast(s) * (1.f / D_) + NORM_EPS);
        if (OUT_F32) { f32x4* o = (f32x4*)((float*)dst + (size_t)m * D_) + lane;
#pragma unroll
            for (int j = 0; j < 8; ++j) o[64 * j] = v[j] * rstd * gv[j];
        } else { v2u* o = (v2u*)((bf16*)dst + (size_t)m * D_) + lane;
#pragma unroll
            for (int j = 0; j < 8; ++j) { const f32x4 y = v[j] * rstd * gv[j]; v2u w; w.x = pk2(y.x, y.y); w.y = pk2(y.z, y.w); o[64 * j] = w; } }
    }
}

struct EpiBf16 {
    static constexpr bool PERM = true, AFTER_DRAIN = false;
    bf16* O; int ldc;
    __device__ __forceinline__ void operator()(const f32x4 (&acc)[2][2][4][2], const pg8::Unit& u, int wr, int wc, int fr, int fq) const {
        const int row0 = u.pm * 256 + wr * 64 + fr, col0 = u.pn * 256 + wc * 32 + 8 * fq;
#pragma unroll
        for (int ai = 0; ai < 2; ++ai)
#pragma unroll
            for (int m = 0; m < 4; ++m) { bf16* rowp = O + (size_t)(row0 + ai * 128 + m * 16) * ldc + col0;
#pragma unroll
                for (int bj = 0; bj < 2; ++bj) { const f32x4 v0 = acc[ai][bj][m][0], v1 = acc[ai][bj][m][1];
                    v4u o; o.x = pk2(v0[0], v0[1]); o.y = pk2(v0[2], v0[3]); o.z = pk2(v1[0], v1[1]); o.w = pk2(v1[2], v1[3]);
                    *(v4u*)(rowp + bj * 128) = o; } }
    }
};
struct EpiBf16Rs {
    static constexpr bool PERM = true, AFTER_DRAIN = false;
    bf16* O; int ldc; const float* ss; const LAS float* RS; int pm_tab;
    __device__ __forceinline__ void operator()(const f32x4 (&acc)[2][2][4][2], const pg8::Unit& u, int wr, int wc, int fr, int fq) const {
        const int rl0 = wr * 64 + fr, col0 = u.pn * 256 + wc * 32 + 8 * fq;
#pragma unroll
        for (int ai = 0; ai < 2; ++ai)
#pragma unroll
            for (int m = 0; m < 4; ++m) { const int rl = rl0 + ai * 128 + m * 16, row = u.pm * 256 + rl; bf16* rowp = O + (size_t)row * ldc + col0;
                float rs;
                if (u.pm == pm_tab) rs = RS[rl];
                else { float tot = 0.f;
#pragma unroll
                    for (int q = 0; q < 8; ++q) { const f32x4 p4 = *(const f32x4*)(ss + (size_t)row * 32 + 4 * q); tot += (p4.x + p4.y) + (p4.z + p4.w); }
                    rs = 1.f / sqrtf(tot * (1.f / D_) + NORM_EPS); }
#pragma unroll
                for (int bj = 0; bj < 2; ++bj) { const f32x4 v0 = acc[ai][bj][m][0] * rs, v1 = acc[ai][bj][m][1] * rs;
                    v4u o; o.x = pk2(v0[0], v0[1]); o.y = pk2(v0[2], v0[3]); o.z = pk2(v1[0], v1[1]); o.w = pk2(v1[2], v1[3]);
                    *(v4u*)(rowp + bj * 128) = o; } }
    }
};
struct EpiLora {
    static constexpr bool PERM = true, AFTER_DRAIN = true;
    AP a; int l; bool dry;
    __device__ __forceinline__ void after(const f32x4 (&acc)[2][2][4][2], const pg8::Unit& u, int wr, int wc, int fr, int fq, LAS unsigned char*) const {
        const float* w0 = (const float*)a->in[I_W0] + l * 512; const float* a0 = (const float*)a->in[I_A0] + l * 512; const float* k_a = (const float*)a->in[I_KA] + l * 512; bf16* rw = (bf16*)(a->ws + WS_RW);
        const int ln_ = (int)lane_id_now();
        const int fr_ = ln_ & 15, fq_ = ln_ >> 4;
        const int row0 = u.pm * 256 + wr * 64 + fr_, col0 = u.pn * 256 + wc * 32 + 8 * fq_;
        if (u.pn < 2) {
#pragma unroll
            for (int bj = 0; bj < 2; ++bj) { const int col = col0 + bj * 128;
                float wv[8]; *(f32x4*)&wv[0] = *(const f32x4*)(w0 + col); *(f32x4*)&wv[4] = *(const f32x4*)(w0 + col + 4);
#pragma unroll
                for (int ai = 0; ai < 2; ++ai)
#pragma unroll
                    for (int m = 0; m < 4; ++m) { const size_t o = (size_t)(row0 + ai * 128 + m * 16) * 512 + col; float ev[8];
#pragma unroll
                        for (int e = 0; e < 8; ++e) { const float nx = -(wv[e] + acc[ai][bj][m][e >> 2][e & 3]); const float sp = fmaxf(nx, 0.f) + log_raw(1.f + exp_raw(-fabsf(nx))); ev[e] = exp_raw(-sp - 0.5f); }
                        *(v4u*)(rw + 5 * RW_STRIDE + o) = pack8(ev); __builtin_amdgcn_sched_barrier(0); } }
        } else {
#pragma unroll
            for (int bj = 0; bj < 2; ++bj) { const int c = col0 + bj * 128 - 512; float av[8], kav[8];
                *(f32x4*)&av[0] = *(const f32x4*)(a0 + c); *(f32x4*)&av[4] = *(const f32x4*)(a0 + c + 4); *(f32x4*)&kav[0] = *(const f32x4*)(k_a + c); *(f32x4*)&kav[4] = *(const f32x4*)(k_a + c + 4);
                v4u kr_[2][4];
#pragma unroll
                for (int ai = 0; ai < 2; ++ai)
#pragma unroll
                    for (int m = 0; m < 4; ++m) kr_[ai][m] = *(const v4u*)(rw + 1 * RW_STRIDE + (size_t)(row0 + ai * 128 + m * 16) * 512 + c);
#pragma unroll
                for (int ai = 0; ai < 2; ++ai)
#pragma unroll
                    for (int m = 0; m < 4; ++m) { const size_t o = (size_t)(row0 + ai * 128 + m * 16) * 512 + c; float al[8], k8[8], kp[8];
                        unpack8(kr_[ai][m], k8);
#pragma unroll
                        for (int e = 0; e < 8; ++e) { al[e] = rcp_raw(1.f + exp_raw(-(av[e] + acc[ai][bj][m][e >> 2][e & 3]))); kp[e] = k8[e] * (1.f + (al[e] - 1.f) * kav[e]); }
                        *(v4u*)(rw + 4 * RW_STRIDE + o) = pack8(al);
                        if (!dry) *(v4u*)(rw + 1 * RW_STRIDE + o) = pack8(kp); __builtin_amdgcn_sched_barrier(0); } }
        }
    }
};
struct EpiGlu {
    static constexpr bool PERM = true, AFTER_DRAIN = false;
    const bf16* G; const float* bias; const bf16* proj; bf16* mixed;
    __device__ __forceinline__ void operator()(const f32x4 (&acc)[2][2][4][2], const pg8::Unit& u, int wr, int wc, int fr, int fq) const {
        const int row0 = u.pm * 256 + wr * 64 + fr, col0 = u.pn * 256 + wc * 32 + 8 * fq;
        float bv[2][8];
#pragma unroll
        for (int bj = 0; bj < 2; ++bj) { *(f32x4*)&bv[bj][0] = *(const f32x4*)(bias + col0 + bj * 128); *(f32x4*)&bv[bj][4] = *(const f32x4*)(bias + col0 + bj * 128 + 4); }
#pragma unroll
        for (int ai = 0; ai < 2; ++ai) {
            v4u gr[4][2], tr[4][2];
#pragma unroll
            for (int m = 0; m < 4; ++m)
#pragma unroll
                for (int bj = 0; bj < 2; ++bj) { const int row = row0 + ai * 128 + m * 16, col = col0 + bj * 128;
                    gr[m][bj] = *(const v4u*)(G + (size_t)row * 512 + col); tr[m][bj] = *(const v4u*)(proj + (size_t)row * LDP + C_GATE + 512 + col); }
#pragma unroll
            for (int m = 0; m < 4; ++m) { const int row = row0 + ai * 128 + m * 16;
#pragma unroll
                for (int bj = 0; bj < 2; ++bj) { const int col = col0 + bj * 128;
                    float gv[8], gt[8], r[8]; unpack8(gr[m][bj], gv); unpack8(tr[m][bj], gt);
#pragma unroll
                    for (int e = 0; e < 8; ++e) { const float x = acc[ai][bj][m][e >> 2][e & 3] + bv[bj][e]; r[e] = gv[e] * sigmoidf_(x) * siluf_(gt[e]); }
                    *(v4u*)(mixed + (size_t)row * D_ + 512 + col) = pack8(r); } }
        }
    }
};
struct EpiResid {
    static constexpr bool PERM = false, AFTER_DRAIN = false;
    const float* xin; float* out;
    __device__ __forceinline__ void operator()(const f32x4 (&acc)[2][2][4][2], const pg8::Unit& u, int wr, int wc, int fr, int fq) const {
        const int row0 = u.pm * 256 + wr * 64 + fr, col0 = u.pn * 256 + wc * 32 + 4 * fq;
#pragma unroll
        for (int ai = 0; ai < 2; ++ai)
#pragma unroll
            for (int m = 0; m < 4; ++m) { const size_t ro = (size_t)(row0 + ai * 128 + m * 16) * D_ + col0;
#pragma unroll
                for (int bj = 0; bj < 2; ++bj)
#pragma unroll
                    for (int n = 0; n < 2; ++n) *(f32x4*)(out + ro + bj * 128 + n * 16) = *(const f32x4*)(xin + ro + bj * 128 + n * 16) + acc[ai][bj][m][n]; }
    }
};
struct EpiResidX {
    static constexpr bool PERM = true, AFTER_DRAIN = false;
    const float* xin_f; const bf16* xin_b; bf16* xout_b; float* xout_f; float* ssn;
    __device__ __forceinline__ void operator()(const f32x4 (&acc)[2][2][4][2], const pg8::Unit& u, int wr, int wc, int fr, int fq) const {
        const int row0 = u.pm * 256 + wr * 64 + fr, col0 = u.pn * 256 + wc * 32 + 8 * fq;
#pragma unroll
        for (int ai = 0; ai < 2; ++ai) {
            float x[4][2][8];
            if (xin_f) {
#pragma unroll
                for (int m = 0; m < 4; ++m)
#pragma unroll
                    for (int bj = 0; bj < 2; ++bj) { const float* p = xin_f + (size_t)(row0 + ai * 128 + m * 16) * D_ + col0 + bj * 128; *(f32x4*)&x[m][bj][0] = *(const f32x4*)p; *(f32x4*)&x[m][bj][4] = *(const f32x4*)(p + 4); }
            } else { v4u raw[4][2];
#pragma unroll
                for (int m = 0; m < 4; ++m)
#pragma unroll
                    for (int bj = 0; bj < 2; ++bj) raw[m][bj] = *(const v4u*)(xin_b + (size_t)(row0 + ai * 128 + m * 16) * D_ + col0 + bj * 128);
#pragma unroll
                for (int m = 0; m < 4; ++m)
#pragma unroll
                    for (int bj = 0; bj < 2; ++bj) unpack8(raw[m][bj], x[m][bj]);
            }
#pragma unroll
            for (int m = 0; m < 4; ++m) { const int row = row0 + ai * 128 + m * 16; const size_t ro = (size_t)row * D_ + col0; float sq = 0.f;
#pragma unroll
                for (int bj = 0; bj < 2; ++bj) { float y[8];
#pragma unroll
                    for (int e = 0; e < 8; ++e) { y[e] = x[m][bj][e] + acc[ai][bj][m][e >> 2][e & 3]; sq += y[e] * y[e]; }
                    if (xout_f) { *(f32x4*)(xout_f + ro + bj * 128) = (f32x4){y[0], y[1], y[2], y[3]}; *(f32x4*)(xout_f + ro + bj * 128 + 4) = (f32x4){y[4], y[5], y[6], y[7]}; }
                    else *(v4u*)(xout_b + ro + bj * 128) = pack8(y); }
                if (!xout_f) { sq += __shfl_xor(sq, 16); sq += __shfl_xor(sq, 32);
                    if (fq == 0) ssn[(size_t)row * 32 + u.pn * 4 + wc] = sq; } }
        }
    }
};
constexpr int PT = 4;
struct PrepRaw { v4u cq, us5, zc[3], zp[3]; v2u ckv; unsigned short kr1, kr2, qd1, qd2, kd1, kd2, wc, wp, ac, ap; float cA, sA, cD, sD; };
__device__ __forceinline__ void phase_prep(AP a, int l, int gw, int NGW, int lane, bool do_rope) {
    bf16* proj = (bf16*)(a->ws + WS_PROJ);
    bf16* cqn = (bf16*)(a->ws + WS_CQN); bf16* ckvn = (bf16*)(a->ws + WS_CKVN); bf16* kr = (bf16*)(a->ws + WS_KR);
    const float* cA = (const float*)(a->ws + WS_ROPEA); const float* sA = cA + (size_t)M_ * 32; const float* cD = (const float*)(a->ws + WS_ROPED); const float* sD = cD + (size_t)M_ * 8;
    bf16* rw = (bf16*)(a->ws + WS_RW);
    const float* gq = (const float*)a->in[I_QNG] + l * 512; const float* gkv = (const float*)a->in[I_KVNG] + l * 256;
    const float* mu = (const float*)a->in[I_MU] + l * 1664;
    const float* k_k = (const float*)a->in[I_KK] + l * 512;
    bf16* wla = (bf16*)(a->ws + WS_WLA);
    const int l31 = lane & 31, ch = lane >> 3, j = lane & 7;
    for (int pr = gw; pr < M_ / PT; pr += NGW) {
        PrepRaw R[PT];
#pragma unroll
        for (int tt = 0; tt < PT; ++tt) {
            const int m = PT * pr + tt; const bool has_prev = (m % S_) != 0;
            const bf16* prow = proj + (size_t)m * LDP; const bf16* pprev = has_prev ? prow - LDP : prow;
            R[tt].cq = *(const v4u*)(prow + C_CQ + lane * 8); R[tt].ckv = *(const v2u*)(prow + C_CKV + lane * 4);
            R[tt].kr1 = prow[C_KR + l31]; R[tt].kr2 = prow[C_KR + 32 + l31]; R[tt].cA = cA[(size_t)m * 32 + l31]; R[tt].sA = sA[(size_t)m * 32 + l31];
            R[tt].qd1 = prow[C_QD + ch * 64 + j]; R[tt].qd2 = prow[C_QD + ch * 64 + j + 8]; R[tt].kd1 = prow[C_KD + ch * 64 + j]; R[tt].kd2 = prow[C_KD + ch * 64 + j + 8];
            R[tt].cD = cD[(size_t)m * 8 + j]; R[tt].sD = sD[(size_t)m * 8 + j];
            R[tt].us5 = *(const v4u*)(prow + C_US5 + lane * 8);
#pragma unroll
            for (int sec = 0; sec < 3; ++sec) { R[tt].zc[sec] = *(const v4u*)(prow + C_R + sec * 512 + lane * 8); R[tt].zp[sec] = *(const v4u*)(pprev + C_R + sec * 512 + lane * 8); }
            R[tt].wc = prow[C_WLO + lane]; R[tt].wp = pprev[C_WLO + lane]; R[tt].ac = prow[C_ALO + lane]; R[tt].ap = pprev[C_ALO + lane];
        }
#pragma unroll
        for (int tt = 0; tt < PT; ++tt) {
            const int m = PT * pr + tt; const bool has_prev = (m % S_) != 0;
            bf16* prow = proj + (size_t)m * LDP;
            { float x[8]; unpack8(R[tt].cq, x); float ss = 0.f;
#pragma unroll
              for (int e = 0; e < 8; ++e) ss += x[e] * x[e];
              const float rstd = 1.f / sqrtf(wave_sum_fast(ss) * (1.f / 512.f) + NORM_EPS);
              const f32x4 g0 = *(const f32x4*)(gq + lane * 8), g1 = *(const f32x4*)(gq + lane * 8 + 4);
#pragma unroll
              for (int e = 0; e < 8; ++e) x[e] = x[e] * rstd * (e < 4 ? g0[e & 3] : g1[e & 3]);
              *(v4u*)(cqn + (size_t)m * 512 + lane * 8) = pack8(x); }
            { const v2u w = R[tt].ckv; float x0 = bflo(w.x), x1 = bfhi(w.x), x2 = bflo(w.y), x3 = bfhi(w.y);
              const float rstd = 1.f / sqrtf(wave_sum_fast(x0 * x0 + x1 * x1 + x2 * x2 + x3 * x3) * (1.f / 256.f) + NORM_EPS);
              const f32x4 g = *(const f32x4*)(gkv + lane * 4);
              v2u o; o.x = pk2(x0 * rstd * g.x, x1 * rstd * g.y); o.y = pk2(x2 * rstd * g.z, x3 * rstd * g.w);
              *(v2u*)(ckvn + (size_t)m * 256 + lane * 4) = o; }
            { const float x1 = bf1(R[tt].kr1), x2 = bf1(R[tt].kr2), c = R[tt].cA, sn = R[tt].sA;
              if (lane < 32) { kr[(size_t)m * 64 + lane] = f2bf(x1 * c - x2 * sn); kr[(size_t)m * 64 + 32 + lane] = f2bf(x2 * c + x1 * sn); } }
            { const float c = R[tt].cD, sn = R[tt].sD; const float q1 = bf1(R[tt].qd1), q2 = bf1(R[tt].qd2), k1 = bf1(R[tt].kd1), k2 = bf1(R[tt].kd2);
              if (do_rope) { bf16* pq = prow + C_QD + ch * 64; bf16* pk = prow + C_KD + ch * 64;
                  pq[j] = f2bf(q1 * c - q2 * sn); pq[j + 8] = f2bf(q2 * c + q1 * sn); pk[j] = f2bf(k1 * c - k2 * sn); pk[j + 8] = f2bf(k2 * c + k1 * sn); } }
            { const int tt_ = m % S_, bb_ = m / S_;
              *(v4u*)((bf16*)(a->ws + WS_ACAT) + ((size_t)((lane >> 1) * 1024 + bb_ * 256 + (tt_ >> 4))) * 384 + (tt_ & 15) * 16 + (lane & 1) * 8) = R[tt].us5; }
            { float zc[8], zp[8], z[8];
#pragma unroll
              for (int sec = 0; sec < 3; ++sec) {
                  unpack8(R[tt].zc[sec], zc); unpack8(R[tt].zp[sec], zp);
                  const f32x4 m0 = *(const f32x4*)(mu + sec * 512 + lane * 8), m1 = *(const f32x4*)(mu + sec * 512 + lane * 8 + 4);
#pragma unroll
                  for (int e = 0; e < 8; ++e) { const float zpe = has_prev ? zp[e] : 0.f; z[e] = zc[e] + (zpe - zc[e]) * (e < 4 ? m0[e & 3] : m1[e & 3]); }
                  *(v4u*)(rw + sec * RW_STRIDE + (size_t)m * 512 + lane * 8) = pack8(z);
                  if (sec == 1) { float kkv[8]; float ss = 0.f;
                      const f32x4 kc0 = *(const f32x4*)(k_k + lane * 8), kc1 = *(const f32x4*)(k_k + lane * 8 + 4);
#pragma unroll
                      for (int e = 0; e < 8; ++e) { kkv[e] = z[e] * (e < 4 ? kc0[e & 3] : kc1[e & 3]); ss += kkv[e] * kkv[e]; }
                      ss = red8(ss); const float inv = 1.f / fmaxf(sqrtf(ss), 1e-12f);
#pragma unroll
                      for (int e = 0; e < 8; ++e) kkv[e] *= inv;
                      *(v4u*)(rw + 3 * RW_STRIDE + (size_t)m * 512 + lane * 8) = pack8(kkv); } }
              const float wc_ = bf1(R[tt].wc), wp_ = has_prev ? bf1(R[tt].wp) : 0.f;
              wla[(size_t)m * 256 + lane] = f2bf(tanh_fast(wc_ + (wp_ - wc_) * mu[1536 + lane]));
              const float ac_ = bf1(R[tt].ac), ap_ = has_prev ? bf1(R[tt].ap) : 0.f;
              wla[(size_t)m * 256 + 64 + lane] = f2bf(ac_ + (ap_ - ac_) * mu[1600 + lane]);
              unsigned z0 = 0u; asm volatile("" : "+v"(z0)); *(unsigned*)(wla + (size_t)m * 256 + 128 + 2 * lane) = z0; }
        }
    }
}

struct S5Par { float abr, abi; f32x2 bb[16]; };
__device__ __forceinline__ void s5_ab(AP a, int l, int g, int p, float& abr, float& abi, float& lr, float& li) {
    lr = fminf(((const float*)a->in[I_S5ARE])[(l * 32 + g) * 64 + p], -1e-4f); li = ((const float*)a->in[I_S5AIM])[(l * 32 + g) * 64 + p];
    const float dt = expf(((const float*)a->in[I_S5LDT])[l * 32 + g]);
    const float mag = expf(dt * lr); float sn, cs; sincosf(dt * li, &sn, &cs); abr = mag * cs; abi = mag * sn;
}
__device__ __forceinline__ void s5_params(AP a, int l, int g, int p, S5Par& P) {
    float lr, li; s5_ab(a, l, g, p, P.abr, P.abi, lr, li);
    const float den = lr * lr + li * li, nr = P.abr - 1.f, ni = P.abi;
    const float fre = (nr * lr + ni * li) / den, fim = (ni * lr - nr * li) / den;
    const float* br = (const float*)a->in[I_S5BRE] + ((size_t)(l * 32 + g) * 64 + p) * 16; const float* bi = (const float*)a->in[I_S5BIM] + ((size_t)(l * 32 + g) * 64 + p) * 16;
#pragma unroll
    for (int c4 = 0; c4 < 4; ++c4) { const f32x4 r = *(const f32x4*)(br + 4 * c4), i = *(const f32x4*)(bi + 4 * c4);
#pragma unroll
        for (int e = 0; e < 4; ++e) P.bb[4 * c4 + e] = (f32x2){fre * r[e] - fim * i[e], fre * i[e] + fim * r[e]}; }
}
constexpr int AT_VSTR = 256;
template <int TYPE> struct AtCfg;
template <> struct AtCfg<0> { static constexpr int DKT = 192, NKS = 12, QR = 256, KSTR = 384, KCH = 24, KPT = 3; };
template <> struct AtCfg<1> { static constexpr int DKT = 128, NKS = 4, QR = 128, KSTR = 256, KCH = 16, KPT = 2; };
__device__ __forceinline__ int crow(int r, int hi) { return (r & 3) + 8 * (r >> 2) + 4 * hi; }

template <int TYPE, int PROBE = 0>
__device__ __forceinline__ void attn_unit(AP a, int l, unsigned char* lds, int b, int hd, int qb, float lam, float lam_init, const int tid) {
    typedef AtCfg<TYPE> C;
    constexpr int STAGE = 64 * C::KSTR + 64 * AT_VSTR;
    const int wid = __builtin_amdgcn_readfirstlane(tid >> 6), lane_ = tid & 63, r32 = lane_ & 31, hi_ = lane_ >> 5;
    const int q0 = qb * C::QR;
    const int qw = q0 + (TYPE == 0 ? wid : (wid & 3)) * 32;
    const int map = TYPE == 0 ? 0 : (wid >> 2);
    const int nkt = (q0 + C::QR) / 64, wnkt = (qw + 31) / 64 + 1;
    const bf16* proj = (const bf16*)(a->ws + WS_PROJ);
    const bf16* kvm = (const bf16*)(a->ws + WS_KVM); const bf16* krp = (const bf16*)(a->ws + WS_KR);
    const size_t tq_ = (size_t)b * S_ + qw + r32;
    bf16x8 q[C::NKS];
    if (TYPE == 0) {
        const bf16* qp = (const bf16*)(a->ws + WS_QM) + tq_ * NQ + hd * 192 + 8 * hi_;
#pragma unroll
        for (int ks = 0; ks < 12; ++ks) q[ks] = *(const bf16x8*)(qp + ks * 16);
        const float* cA = (const float*)(a->ws + WS_ROPEA) + tq_ * 32; const float* sA = (const float*)(a->ws + WS_ROPEA) + (size_t)M_ * 32 + tq_ * 32;
#pragma unroll
        for (int kp = 0; kp < 2; ++kp) {
            float x1[8], x2[8], cs[8], sn[8];
            unpack8(*reinterpret_cast<v4u*>(&q[8 + kp]), x1); unpack8(*reinterpret_cast<v4u*>(&q[10 + kp]), x2);
            *(f32x4*)&cs[0] = *(const f32x4*)(cA + kp * 16 + 8 * hi_); *(f32x4*)&cs[4] = *(const f32x4*)(cA + kp * 16 + 8 * hi_ + 4);
            *(f32x4*)&sn[0] = *(const f32x4*)(sA + kp * 16 + 8 * hi_); *(f32x4*)&sn[4] = *(const f32x4*)(sA + kp * 16 + 8 * hi_ + 4);
            float y1[8], y2[8];
#pragma unroll
            for (int e = 0; e < 8; ++e) { y1[e] = x1[e] * cs[e] - x2[e] * sn[e]; y2[e] = x2[e] * cs[e] + x1[e] * sn[e]; }
            v4u w1 = pack8(y1), w2 = pack8(y2); q[8 + kp] = *reinterpret_cast<bf16x8*>(&w1); q[10 + kp] = *reinterpret_cast<bf16x8*>(&w2);
        }
    } else {
        const bf16* qp = proj + tq_ * LDP + C_QD + hd * 128 + map * 64 + 8 * hi_;
#pragma unroll
        for (int ks = 0; ks < 4; ++ks) q[ks] = *(const bf16x8*)(qp + ks * 16);
    }
    const float Cs = (TYPE == 0 ? 0.07216878364870322f : 0.125f) * 1.4426950408889634f;
    f32x16 o[4];
#pragma unroll
    for (int d = 0; d < 4; ++d)
#pragma unroll
        for (int i = 0; i < 16; ++i) o[d][i] = 0.f;
    float mrun = -INFINITY, lsum = 0.f;
    LAS unsigned char* ldsl = (LAS unsigned char*)lds;
    auto dma = [&](int kt, int buf) {
        const size_t tk0 = (size_t)b * S_ + (size_t)kt * 64;
#pragma unroll
        for (int i = 0; i < C::KPT; ++i) { const int sg = (i * 8 + wid) * 64 + lane_, r = sg / C::KCH, cp = sg % C::KCH;
            const int cc = (TYPE == 0) ? ((cp & ~7) | ((cp & 7) ^ ((r >> 1) & 7))) : (cp ^ (r & 15));
            const bf16* src;
            if (TYPE == 0) src = (cc < 16) ? kvm + (tk0 + r) * NKV + hd * 256 + cc * 8 : krp + (tk0 + r) * 64 + (cc - 16) * 8;
            else src = proj + (tk0 + r) * LDP + C_KD + hd * 128 + cc * 8;
            __builtin_amdgcn_global_load_lds((const unsigned*)src, (LAS unsigned*)(ldsl + buf * STAGE + (i * 8 + wid) * 1024), 16, 0, 0); }
#pragma unroll
        for (int i = 0; i < 2; ++i) { const int sg = (i * 8 + wid) * 64 + lane_, r = sg >> 4, cp = sg & 15, cc = cp ^ ((r & 3) << 2);
            const bf16* src = (TYPE == 0) ? kvm + (tk0 + r) * NKV + hd * 256 + 128 + cc * 8 : proj + (tk0 + r) * LDP + C_VD + hd * 128 + cc * 8;
            __builtin_amdgcn_global_load_lds((const unsigned*)src, (LAS unsigned*)(ldsl + buf * STAGE + 64 * C::KSTR + (i * 8 + wid) * 1024), 16, 0, 0); }
    };
    int koff[4], voff[4];
    {   const int g16 = lane_ >> 4, i16 = lane_ & 15, qq = i16 >> 2, pp = i16 & 3;
#pragma unroll
        for (int x = 0; x < 4; ++x) {
            if (TYPE == 0) { const int f = (r32 >> 1) & 7; koff[x] = r32 * C::KSTR + 16 * ((2 * (x ^ (f >> 1))) + (hi_ ^ (f & 1))); }
            else { const int f = r32 & 15; koff[x] = r32 * C::KSTR + 16 * (8 * (map ^ (f >> 3)) + 2 * (x ^ ((f >> 1) & 3)) + (hi_ ^ (f & 1))); }
            voff[x] = (4 * hi_ + qq) * AT_VSTR + (4 * (x ^ qq) + 2 * (g16 & 1) + (pp >> 1)) * 16 + (pp & 1) * 8;
        }
    }
    dma(0, 0); asm volatile("s_waitcnt vmcnt(0)" ::: "memory"); __syncthreads();
    for (int kt = 0; kt < nkt; ++kt) {
        const bool more = (kt + 1 < nkt);
        if (more) dma(kt + 1, (kt + 1) & 1);
        LAS unsigned char* Kl = ldsl + (kt & 1) * STAGE; LAS unsigned char* Vl = Kl + 64 * C::KSTR;
        const bool active = kt < wnkt;
        if (active) {
            const int k0i = kt * 64;
#pragma unroll
            for (int kb = 0; kb < 2; ++kb) {
                if (kb == 1 && k0i + 32 > qw + 31) break;
                f32x16 s0;
#pragma unroll
                for (int i = 0; i < 16; ++i) s0[i] = 0.f;
                {
                    bf16x8 kf[2][4];
                    const LAS unsigned char* Kb = Kl + kb * 32 * C::KSTR;
#pragma unroll
                    for (int x = 0; x < 4; ++x) kf[0][x] = (PROBE == 3) ? q[x] : *(const LAS bf16x8*)(Kb + koff[x]);
#pragma unroll
                    for (int g = 0; g < C::NKS / 4; ++g) {
                        if (g + 1 < C::NKS / 4) {
#pragma unroll
                            for (int x = 0; x < 4; ++x) kf[(g + 1) & 1][x] = (PROBE == 3) ? q[x] : *(const LAS bf16x8*)(Kb + koff[x] + (g + 1) * 128);
                        }
                        __builtin_amdgcn_sched_barrier(0);
#pragma unroll
                        for (int x = 0; x < 4; ++x) { if (PROBE == 2) { s0[x] += __builtin_bit_cast(float, (int)kf[g & 1][x][0]); } else s0 = __builtin_amdgcn_mfma_f32_32x32x16_bf16(kf[g & 1][x], q[4 * g + x], s0, 0, 0, 0); }
                        __builtin_amdgcn_sched_barrier(0);
                    }
                }
                if (k0i + 32 * kb + 31 > qw) {
                    const int qi = qw + r32;
#pragma unroll
                    for (int i = 0; i < 16; ++i) { const int key = k0i + 32 * kb + crow(i, hi_); if (key > qi) s0[i] = -INFINITY; }
                }
                float tmax = s0[0];
#pragma unroll
                for (int i = 1; i < 16; ++i) if (PROBE != 1) tmax = fmaxf(tmax, s0[i]);
                tmax = pair_max(tmax);
                const float mn = fmaxf(mrun, tmax);
                const float alpha = __builtin_amdgcn_exp2f((mrun - mn) * Cs);
                mrun = mn;
                const float mnC = -mn * Cs; float ps = 0.f;
#pragma unroll
                for (int i = 0; i < 16; ++i) { if (PROBE != 1) { s0[i] = __builtin_amdgcn_exp2f(fmaf(s0[i], Cs, mnC)); ps += s0[i]; } }
                lsum = lsum * alpha + ps;
                if (!__all(alpha == 1.f)) {
#pragma unroll
                    for (int d = 0; d < 4; ++d)
#pragma unroll
                        for (int i = 0; i < 16; ++i) o[d][i] *= alpha;
                }
#pragma unroll
                for (int s2 = 0; s2 < 2; ++s2) {
                    v4u w; w.x = pk2(s0[8 * s2 + 0], s0[8 * s2 + 1]); w.y = pk2(s0[8 * s2 + 2], s0[8 * s2 + 3]); w.z = pk2(s0[8 * s2 + 4], s0[8 * s2 + 5]); w.w = pk2(s0[8 * s2 + 6], s0[8 * s2 + 7]);
                    const bf16x8 pb = *reinterpret_cast<bf16x8*>(&w);
                    const int s = 2 * kb + s2;
                    s16x4 lo[4], hh[4];
                    if (PROBE == 3) {
#pragma unroll
                        for (int d = 0; d < 4; ++d) { lo[d] = (s16x4){pb[0], pb[1], pb[2], pb[3]}; hh[d] = (s16x4){pb[4], pb[5], pb[6], pb[7]}; }
                    } else {
#pragma unroll
                    for (int d = 0; d < 4; ++d) {
                        asm volatile("ds_read_b64_tr_b16 %0, %1 offset:%2" : "=v"(lo[d]) : "v"((unsigned)(size_t)Vl + voff[d]), "i"((16 * s) * AT_VSTR));
                        asm volatile("ds_read_b64_tr_b16 %0, %1 offset:%2" : "=v"(hh[d]) : "v"((unsigned)(size_t)Vl + voff[d]), "i"((16 * s + 8) * AT_VSTR));
                    }
                    asm volatile("s_waitcnt lgkmcnt(0)" : "+v"(lo[0]), "+v"(lo[1]), "+v"(lo[2]), "+v"(lo[3]), "+v"(hh[0]), "+v"(hh[1]), "+v"(hh[2]), "+v"(hh[3]));
                    }
#pragma unroll
                    for (int d = 0; d < 4; ++d) {
                        const bf16x8 va = (bf16x8){lo[d][0], lo[d][1], lo[d][2], lo[d][3], hh[d][0], hh[d][1], hh[d][2], hh[d][3]};
                        if (PROBE == 2) o[d][0] += __builtin_bit_cast(float, (int)va[0] + (int)pb[0]); else o[d] = __builtin_amdgcn_mfma_f32_32x32x16_bf16(va, pb, o[d], 0, 0, 0);
                    }
                }
            }
        }
        asm volatile("s_waitcnt vmcnt(0)" ::: "memory");
        __syncthreads();
    }
    lsum = pair_sum(lsum);
    const float linv = 1.f / lsum;
    bf16* mixed = (bf16*)(a->ws + WS_MIXED);
    const int tid2 = (int)lane_id_now();
    const int lane = tid2 & 63, hi = lane >> 5;
    const size_t tq = (size_t)b * S_ + qw + (lane & 31);
    if (TYPE == 0) {
        const bf16* gp = proj + tq * LDP + C_GATE + hd * 128; bf16* op = mixed + tq * D_ + hd * 128;
        v2u gws[4][4];
#pragma unroll
        for (int d = 0; d < 4; ++d)
#pragma unroll
            for (int ig = 0; ig < 4; ++ig) gws[d][ig] = *(const v2u*)(gp + 32 * d + 8 * ig + 4 * hi);
#pragma unroll
        for (int d = 0; d < 4; ++d)
#pragma unroll
            for (int ig = 0; ig < 4; ++ig) { const int dv = 32 * d + 8 * ig + 4 * hi; const v2u gw = gws[d][ig];
                v2u w; w.x = pk2(o[d][4 * ig + 0] * linv * siluf_(bflo(gw.x)), o[d][4 * ig + 1] * linv * siluf_(bfhi(gw.x)));
                w.y = pk2(o[d][4 * ig + 2] * linv * siluf_(bflo(gw.y)), o[d][4 * ig + 3] * linv * siluf_(bfhi(gw.y)));
                *(v2u*)(op + dv) = w; }
    } else {
        float* X = (float*)lds;
        if (wid >= 4) {
#pragma unroll
            for (int d = 0; d < 4; ++d)
#pragma unroll
                for (int i = 0; i < 16; ++i) X[(((wid - 4) * 4 + d) * 16 + i) * 64 + lane] = o[d][i] * linv;
        }
        __syncthreads();
        if (wid < 4) {
            float ss = 0.f;
#pragma unroll
            for (int d = 0; d < 4; ++d)
#pragma unroll
                for (int i = 0; i < 16; ++i) { const float v = o[d][i] * linv - lam * X[((wid * 4 + d) * 16 + i) * 64 + lane]; o[d][i] = v; ss += v * v; }
            ss = pair_sum(ss);
            const float rstd = (1.f - lam_init) / sqrtf(ss * (1.f / 128.f) + 1e-5f);
            const float* sg = (const float*)a->in[I_SUBG] + l * 128;
            const bf16* gp = proj + tq * LDP + C_GATE + 1536 + hd * 128; bf16* op = mixed + tq * D_ + 1536 + hd * 128;
            v2u gws[4][4]; f32x4 sgs[4][4];
#pragma unroll
            for (int d = 0; d < 4; ++d)
#pragma unroll
                for (int ig = 0; ig < 4; ++ig) { gws[d][ig] = *(const v2u*)(gp + 32 * d + 8 * ig + 4 * hi); sgs[d][ig] = *(const f32x4*)(sg + 32 * d + 8 * ig + 4 * hi); }
#pragma unroll
            for (int d = 0; d < 4; ++d)
#pragma unroll
                for (int ig = 0; ig < 4; ++ig) { const int dv = 32 * d + 8 * ig + 4 * hi; const v2u gw = gws[d][ig]; const f32x4 sgv = sgs[d][ig];
                    v2u w; w.x = pk2(o[d][4 * ig + 0] * rstd * sgv.x * siluf_(bflo(gw.x)), o[d][4 * ig + 1] * rstd * sgv.y * siluf_(bfhi(gw.x)));
                    w.y = pk2(o[d][4 * ig + 2] * rstd * sgv.z * siluf_(bflo(gw.y)), o[d][4 * ig + 3] * rstd * sgv.w * siluf_(bfhi(gw.y)));
                    *(v2u*)(op + dv) = w; }
        }
        __syncthreads();
    }
}
constexpr int CK_MA = 0, CK_MR = 4608, CK_MB = 9216, CK_MK = 13824, CK_MV = 18432, CK_MBH = 23040, CK_MKH = 27648, CK_LAB = 32256, CK_Y2 = 36864,
              CK_MRB = 45568, CK_MRK = 48128, CK_XT = 50688, CK_GT = 60928, CK_TOT = 61184, CK_BYTES = 65536;
constexpr int CK_ROW = 144, CK_TROW = 80, CK_Y2ROW = 272, CK_AFROW = 256;
constexpr size_t WS_QF = 660 * MiB;
constexpr size_t WS_CF = 724 * MiB;

__device__ __forceinline__ f32x16 ck_prod(const LAS unsigned char* LA, const LAS unsigned char* LB, int lane) {
    f32x16 acc;
#pragma unroll
    for (int i = 0; i < 16; ++i) acc[i] = 0.f;
    const int ro = (lane & 31) * CK_ROW + (lane >> 5) * 16;
#pragma unroll
    for (int ks = 0; ks < 4; ++ks) acc = __builtin_amdgcn_mfma_f32_32x32x16_bf16(*(const LAS bf16x8*)(LA + ro + ks * 32), *(const LAS bf16x8*)(LB + ro + ks * 32), acc, 0, 0, 0);
    return acc;
}
template <bool NAT> __device__ __forceinline__ bf16x8 ck_tr(LAS unsigned char* base, int s0, int col0, int lane) {
    const int g16 = lane >> 4, i16 = lane & 15, q = i16 >> 2, p = i16 & 3, hi = lane >> 5;
    const int r0 = NAT ? (s0 + 8 * hi + q) : (s0 + 4 * hi + q), r1 = NAT ? r0 + 4 : r0 + 8;
    const int co = (col0 + 16 * (g16 & 1) + 4 * p) * 2;
    const s16x4 lo = __builtin_amdgcn_ds_read_tr16_b64_v4i16((LAS s16x4*)(base + r0 * CK_ROW + co));
    const s16x4 hh = __builtin_amdgcn_ds_read_tr16_b64_v4i16((LAS s16x4*)(base + r1 * CK_ROW + co));
    return (bf16x8){lo[0], lo[1], lo[2], lo[3], hh[0], hh[1], hh[2], hh[3]};
}
__device__ __forceinline__ bf16x8 pack_bf8(const f32x16& x, int o) { v4u w; w.x = pk2(x[o], x[o + 1]); w.y = pk2(x[o + 2], x[o + 3]); w.z = pk2(x[o + 4], x[o + 5]); w.w = pk2(x[o + 6], x[o + 7]); return *reinterpret_cast<bf16x8*>(&w); }

struct CkPre { v4u r, k, v, kk, al, ee; };
__device__ __forceinline__ void ck_prefetch(AP a, int u, const int tid_, CkPre& p) {
    int tid = tid_; asm volatile("" : "+v"(tid));
    const int hp = u & 3, ch = (u >> 2) & 127, b = u >> 9, g = tid >> 8, t2 = tid & 255, st = t2 >> 3, cg = t2 & 7, hd = 2 * hp + g;
    const bf16* rw = (const bf16*)(a->ws + WS_RW) + ((size_t)b * S_ + (size_t)ch * 32 + st) * 512 + hd * 64 + cg * 8;
    p.r = *(const v4u*)(rw + 0 * RW_STRIDE); p.k = *(const v4u*)(rw + 1 * RW_STRIDE); p.v = *(const v4u*)(rw + 2 * RW_STRIDE);
    p.kk = *(const v4u*)(rw + 3 * RW_STRIDE); p.al = *(const v4u*)(rw + 4 * RW_STRIDE); p.ee = *(const v4u*)(rw + 5 * RW_STRIDE);
}
struct QTicket;
__device__ __forceinline__ int q_next(QTicket& t, unsigned* head, unsigned limit, volatile LAS unsigned* slot, int wave_idx);
__device__ __forceinline__ int rwkv_chunk_unit(AP a, int l, unsigned char* lds, int u, const int tid_, const bool dry, CkPre& pre, QTicket& qt, unsigned* qhead, unsigned qlimit, volatile LAS unsigned* qslot, int wave_s) {
    int tid = tid_; asm volatile("" : "+v"(tid));
    const int hp = u & 3, ch = (u >> 2) & 127, b = u >> 9;
    const int g = tid >> 8, t2 = tid & 255, st = t2 >> 3, cg = t2 & 7, hd = 2 * hp + g, w4 = __builtin_amdgcn_readfirstlane((tid >> 6) & 3), lane = tid & 63, hi = lane >> 5, r32 = lane & 31;
    LAS unsigned char* L = (LAS unsigned char*)lds + g * CK_BYTES;
    bf16* rw = (bf16*)(a->ws + WS_RW);
    const size_t tok0 = (size_t)b * S_ + (size_t)ch * 32, chid = ((size_t)b * 128 + ch) * 8 + hd;
    {   const size_t o = (tok0 + st) * 512 + hd * 64 + cg * 8;
        float r[8], k[8], kk[8], al[8], ee[8];
        unpack8(pre.r, r); unpack8(pre.k, k); unpack8(pre.kk, kk); unpack8(pre.al, al); unpack8(pre.ee, ee);
        const v4u vraw = pre.v;
        float inc[8];
#pragma unroll
        for (int e = 0; e < 8; ++e) { float x = ee[e];
#pragma unroll
            for (int d = 8; d < 64; d <<= 1) { const float up = shfl_up_l(x, d, lane); if (lane >= d) x += up; }
            inc[e] = x; }
        LAS float* TOT = (LAS float*)(L + CK_TOT);
        if ((lane >> 3) == 7) { *(LAS f32x4*)(TOT + w4 * 64 + cg * 8) = (f32x4){inc[0], inc[1], inc[2], inc[3]}; *(LAS f32x4*)(TOT + w4 * 64 + cg * 8 + 4) = (f32x4){inc[4], inc[5], inc[6], inc[7]}; }
        __syncthreads();
        float lamp[8], lamT[8];
#pragma unroll
        for (int e = 0; e < 8; ++e) { lamp[e] = inc[e] - ee[e]; lamT[e] = 0.f; }
#pragma unroll
        for (int w2 = 0; w2 < 4; ++w2) { const f32x4 t0 = *(const LAS f32x4*)(TOT + w2 * 64 + cg * 8), t1 = *(const LAS f32x4*)(TOT + w2 * 64 + cg * 8 + 4);
#pragma unroll
            for (int e = 0; e < 4; ++e) { lamT[e] += t0[e]; lamT[4 + e] += t1[e]; if (w2 < w4) { lamp[e] += t0[e]; lamp[4 + e] += t1[e]; } } }
        float at[8], rt[8], bt[8], kt[8], bh[8], kh[8];
#pragma unroll
        for (int e = 0; e < 8; ++e) { const float lc = lamp[e] + ee[e]; const float gp = __expf(-lamp[e]), gi = __expf(lc), gcur = __expf(-lc), gend = __expf(lc - lamT[e]);
            const float bv = kk[e] * al[e]; at[e] = -kk[e] * gp; rt[e] = r[e] * gcur; bt[e] = bv * gi; kt[e] = k[e] * gi; bh[e] = bv * gend; kh[e] = k[e] * gend; }
        const int ro = st * CK_ROW + cg * 16;
        *(LAS v4u*)(L + CK_MA + ro) = pack8(at); *(LAS v4u*)(L + CK_MR + ro) = pack8(rt); *(LAS v4u*)(L + CK_MB + ro) = pack8(bt); *(LAS v4u*)(L + CK_MK + ro) = pack8(kt);
        *(LAS v4u*)(L + CK_MV + ro) = vraw; *(LAS v4u*)(L + CK_MBH + ro) = pack8(bh); *(LAS v4u*)(L + CK_MKH + ro) = pack8(kh);
        LAS float* AF = (LAS float*)(L + CK_XT + st * CK_AFROW + cg * 32);
        *(LAS f32x4*)AF = (f32x4){at[0], at[1], at[2], at[3]}; *(LAS f32x4*)(AF + 4) = (f32x4){at[4], at[5], at[6], at[7]};
        if (st == 31) { float gT[8];
#pragma unroll
            for (int e = 0; e < 8; ++e) gT[e] = __expf(-lamT[e]);
            LAS float* G = (LAS float*)(L + CK_GT) + cg * 8; *(LAS f32x4*)G = (f32x4){gT[0], gT[1], gT[2], gT[3]}; *(LAS f32x4*)(G + 4) = (f32x4){gT[4], gT[5], gT[6], gT[7]};
            float* gg = (float*)(a->ws + WS_RWGT) + chid * 64 + cg * 8; *(f32x4*)gg = (f32x4){gT[0], gT[1], gT[2], gT[3]}; *(f32x4*)(gg + 4) = (f32x4){gT[4], gT[5], gT[6], gT[7]}; }
    }
    __syncthreads();
    if (w4 == 0) {
        const f32x16 acc = ck_prod(L + CK_MA, L + CK_MB, lane);
#pragma unroll
        for (int m = 0; m < 4; ++m) { const int t0 = 8 * m + 4 * hi;
            *(LAS f32x4*)(L + CK_LAB + r32 * CK_ROW + t0 * 4) = (f32x4){(r32 < t0) ? acc[4 * m] : 0.f, (r32 < t0 + 1) ? acc[4 * m + 1] : 0.f, (r32 < t0 + 2) ? acc[4 * m + 2] : 0.f, (r32 < t0 + 3) ? acc[4 * m + 3] : 0.f}; }
    } else if (w4 == 1) {
        f32x16 acc = ck_prod(L + CK_MK, L + CK_MA, lane);
#pragma unroll
        for (int i = 0; i < 16; ++i) if (!(crow(i, hi) < r32)) acc[i] = 0.f;
        const bf16x8 pb0 = pack_bf8(acc, 0), pb1 = pack_bf8(acc, 8);
#pragma unroll
        for (int vb = 0; vb < 2; ++vb) { f32x16 y;
#pragma unroll
            for (int i = 0; i < 16; ++i) y[i] = 0.f;
            y = __builtin_amdgcn_mfma_f32_32x32x16_bf16(ck_tr<false>(L + CK_MV, 0, 32 * vb, lane), pb0, y, 0, 0, 0);
            y = __builtin_amdgcn_mfma_f32_32x32x16_bf16(ck_tr<false>(L + CK_MV, 16, 32 * vb, lane), pb1, y, 0, 0, 0);
#pragma unroll
            for (int m = 0; m < 4; ++m) *(LAS f32x4*)(L + CK_Y2 + r32 * CK_Y2ROW + (32 * vb + 8 * m + 4 * hi) * 4) = (f32x4){y[4 * m], y[4 * m + 1], y[4 * m + 2], y[4 * m + 3]}; }
    } else {
        const f32x16 acc = ck_prod(L + (w4 == 2 ? CK_MB : CK_MK), L + CK_MR, lane);
        LAS unsigned char* D = L + (w4 == 2 ? CK_MRB : CK_MRK) + r32 * CK_TROW;
#pragma unroll
        for (int m = 0; m < 4; ++m) { float x[4];
#pragma unroll
            for (int e = 0; e < 4; ++e) x[e] = (8 * m + 4 * hi + e <= r32) ? acc[4 * m + e] : 0.f;
            v2u w; w.x = pk2(x[0], x[1]); w.y = pk2(x[2], x[3]); *(LAS v2u*)(D + (8 * m + 4 * hi) * 2) = w; }
    }
    __syncthreads();
    float x[32];
#pragma unroll
    for (int t = 0; t < 32; ++t) x[t] = 0.f;
    if (w4 < 2) {
        const LAS unsigned char* rhs = (w4 == 0) ? (L + CK_XT + lane * 4) : (L + CK_Y2 + lane * 4);
        const int rstride = (w4 == 0) ? CK_AFROW : CK_Y2ROW;
#pragma unroll
        for (int t = 0; t < 32; ++t) x[t] = *(const LAS float*)(rhs + t * rstride);
#pragma unroll
        for (int s_ = 0; s_ < 31; ++s_) {
#pragma unroll
            for (int t4 = (s_ + 1) / 4; t4 < 8; ++t4) { const f32x4 lv = *(const LAS f32x4*)(L + CK_LAB + s_ * CK_ROW + t4 * 16);
#pragma unroll
                for (int e = 0; e < 4; ++e) if (4 * t4 + e > s_) x[4 * t4 + e] += lv[e] * x[s_]; }
        }
    }
    __syncthreads();
    if (w4 < 2) { LAS unsigned char* D = L + CK_XT + (w4 * 64 + lane) * CK_TROW;
#pragma unroll
        for (int q = 0; q < 4; ++q) { v4u w; w.x = pk2(x[8 * q], x[8 * q + 1]); w.y = pk2(x[8 * q + 2], x[8 * q + 3]); w.z = pk2(x[8 * q + 4], x[8 * q + 5]); w.w = pk2(x[8 * q + 6], x[8 * q + 7]); *(LAS v4u*)(D + q * 16) = w; } }
    const int nu = q_next(qt, qhead, qlimit, qslot, wave_s);
    if (nu < (int)qlimit) ck_prefetch(a, nu, tid, pre);
    int lane4 = tid & 63; asm volatile("" : "+v"(lane4));
    const int hi4 = lane4 >> 5, r4 = lane4 & 31;
    const int ko = hi4 * 16;
    if (w4 == 0) {
        bf16* rh = rw + 3 * RW_STRIDE;
#pragma unroll
        for (int kb = 0; kb < 2; ++kb) { f32x16 acc;
#pragma unroll
            for (int i = 0; i < 16; ++i) acc[i] = 0.f;
#pragma unroll
            for (int ks = 0; ks < 2; ++ks) acc = __builtin_amdgcn_mfma_f32_32x32x16_bf16(*(const LAS bf16x8*)(L + CK_XT + (32 * kb + r4) * CK_TROW + ks * 32 + ko), *(const LAS bf16x8*)(L + CK_MRB + r4 * CK_TROW + ks * 32 + ko), acc, 0, 0, 0);
#pragma unroll
            for (int m = 0; m < 4; ++m) { const int kc = 32 * kb + 8 * m + 4 * hi4; const v2u rr = *(const LAS v2u*)(L + CK_MR + r4 * CK_ROW + kc * 2);
                v2u w; w.x = pk2(acc[4 * m] + bflo(rr.x), acc[4 * m + 1] + bfhi(rr.x)); w.y = pk2(acc[4 * m + 2] + bflo(rr.y), acc[4 * m + 3] + bfhi(rr.y));
                if (!dry) *(v2u*)(rh + (tok0 + r4) * 512 + hd * 64 + kc) = w; else asm volatile("" :: "v"(w.x), "v"(w.y)); } }
    } else if (w4 == 1) {
        float* rwo = (float*)(a->ws + WS_RWO);
#pragma unroll
        for (int vb = 0; vb < 2; ++vb) { f32x16 acc;
#pragma unroll
            for (int i = 0; i < 16; ++i) acc[i] = 0.f;
#pragma unroll
            for (int ks = 0; ks < 2; ++ks) {
                acc = __builtin_amdgcn_mfma_f32_32x32x16_bf16(*(const LAS bf16x8*)(L + CK_XT + (64 + 32 * vb + r4) * CK_TROW + ks * 32 + ko), *(const LAS bf16x8*)(L + CK_MRB + r4 * CK_TROW + ks * 32 + ko), acc, 0, 0, 0);
                acc = __builtin_amdgcn_mfma_f32_32x32x16_bf16(ck_tr<true>(L + CK_MV, 16 * ks, 32 * vb, lane4), *(const LAS bf16x8*)(L + CK_MRK + r4 * CK_TROW + ks * 32 + ko), acc, 0, 0, 0); }
#pragma unroll
            for (int m = 0; m < 4; ++m) *(f32x4*)(rwo + (tok0 + r4) * 512 + hd * 64 + 32 * vb + 8 * m + 4 * hi4) = (f32x4){acc[4 * m], acc[4 * m + 1], acc[4 * m + 2], acc[4 * m + 3]}; }
    } else if (w4 == 2) {
        bf16* cf = (bf16*)(a->ws + WS_CF) + chid * 4096;
#pragma unroll
        for (int k1b = 0; k1b < 2; ++k1b)
#pragma unroll
            for (int k2b = 0; k2b < 2; ++k2b) { f32x16 acc;
#pragma unroll
                for (int i = 0; i < 16; ++i) acc[i] = 0.f;
#pragma unroll
                for (int ks = 0; ks < 2; ++ks) acc = __builtin_amdgcn_mfma_f32_32x32x16_bf16(*(const LAS bf16x8*)(L + CK_XT + (32 * k1b + r4) * CK_TROW + ks * 32 + ko), ck_tr<true>(L + CK_MBH, 16 * ks, 32 * k2b, lane4), acc, 0, 0, 0);
#pragma unroll
                for (int ks = 0; ks < 2; ++ks) { const bf16x8 f = pack_bf8(acc, 8 * ks); *(bf16x8*)(cf + (size_t)(((k1b * 2 + k2b) * 2 + ks) * 64 + lane4) * 8) = f; } }
    } else {
        float* qf = (float*)(a->ws + WS_QF) + chid * 4096;
#pragma unroll
        for (int kb = 0; kb < 2; ++kb)
#pragma unroll
            for (int vb = 0; vb < 2; ++vb) { f32x16 acc;
#pragma unroll
                for (int i = 0; i < 16; ++i) acc[i] = 0.f;
#pragma unroll
                for (int ks = 0; ks < 2; ++ks) {
                    acc = __builtin_amdgcn_mfma_f32_32x32x16_bf16(ck_tr<true>(L + CK_MBH, 16 * ks, 32 * kb, lane4), *(const LAS bf16x8*)(L + CK_XT + (64 + 32 * vb + r4) * CK_TROW + ks * 32 + ko), acc, 0, 0, 0);
                    acc = __builtin_amdgcn_mfma_f32_32x32x16_bf16(ck_tr<true>(L + CK_MKH, 16 * ks, 32 * kb, lane4), ck_tr<true>(L + CK_MV, 16 * ks, 32 * vb, lane4), acc, 0, 0, 0); }
#pragma unroll
                for (int m = 0; m < 4; ++m) *(f32x4*)(qf + (size_t)(((kb * 2 + vb) * 4 + m) * 64 + lane4) * 4) = (f32x4){acc[4 * m], acc[4 * m + 1], acc[4 * m + 2], acc[4 * m + 3]}; }
    }
    __syncthreads();
    return nu;
}

constexpr int SC_Q = 0, SC_C = 16384, SC_R = 24576, SC_G = 28672, SC_SLOT = 29696, SC_NSLOT = 4;
constexpr size_t WS_ZB = 756 * MiB;
__device__ __forceinline__ void rwkv_scan_unit(AP a, unsigned char* lds, int u, const int tid, const bool dry, unsigned* done) {
    const int wid = __builtin_amdgcn_readfirstlane(tid >> 6), lane = tid & 63, hi = lane >> 5, r32 = lane & 31;
    const int b = u >> 3, hd = u & 7;
    LAS unsigned char* ldsl = (LAS unsigned char*)lds;
    const char* rhb = (const char*)((const bf16*)(a->ws + WS_RW) + 3 * RW_STRIDE); float* zb = (float*)(a->ws + WS_ZB);
    const char* qfb = (const char*)(a->ws + WS_QF); const char* cfb = (const char*)(a->ws + WS_CF); const char* gtb = (const char*)(a->ws + WS_RWGT);
    const int mj = (wid - 2) >> 1, mm = wid & 1;
    auto move = [&](int ch) {
        const size_t chid = ((size_t)b * 128 + ch) * 8 + hd; const int so = (ch & 3) * SC_SLOT;
        if (mm == 0) {
#pragma unroll
            for (int i = 0; i < 16; ++i) __builtin_amdgcn_global_load_lds((const unsigned*)(qfb + chid * 16384 + i * 1024 + lane * 16), (LAS unsigned*)(ldsl + so + SC_Q + i * 1024), 16, 0, 0);
        } else {
#pragma unroll
            for (int i = 0; i < 8; ++i) __builtin_amdgcn_global_load_lds((const unsigned*)(cfb + chid * 8192 + i * 1024 + lane * 16), (LAS unsigned*)(ldsl + so + SC_C + i * 1024), 16, 0, 0);
            const size_t tok0 = (size_t)b * S_ + (size_t)ch * 32;
#pragma unroll
            for (int i = 0; i < 4; ++i) __builtin_amdgcn_global_load_lds((const unsigned*)(rhb + ((tok0 + i * 8 + (lane >> 3)) * 512 + hd * 64) * 2 + (lane & 7) * 16), (LAS unsigned*)(ldsl + so + SC_R + i * 1024), 16, 0, 0);
            __builtin_amdgcn_global_load_lds((const unsigned*)(gtb + (chid - (hd & 3)) * 256 + lane * 16), (LAS unsigned*)(ldsl + so + SC_G), 16, 0, 0);
        }
    };
    f32x16 st0, st1;
#pragma unroll
    for (int i = 0; i < 16; ++i) { st0[i] = 0.f; st1[i] = 0.f; }
    if (wid >= 2) { move(mj); if (mj == 0) asm volatile("s_waitcnt vmcnt(0)" ::: "memory"); }
    __syncthreads();
    for (int ch = 0; ch < 128; ++ch) {
        if (wid >= 2) {
            if (ch % 3 == mj) { if (ch + 3 < 128) move(ch + 3); }
            if ((ch + 1) % 3 == mj) asm volatile("s_waitcnt vmcnt(0)" ::: "memory");
        } else {
            const int vb = wid; const LAS unsigned char* P = ldsl + (ch & 3) * SC_SLOT;
            f32x16 n0, n1;
#pragma unroll
            for (int m = 0; m < 4; ++m) {
                const f32x4 q0 = *(const LAS f32x4*)(P + SC_Q + (((0 * 2 + vb) * 4 + m) * 64 + lane) * 16), q1 = *(const LAS f32x4*)(P + SC_Q + (((1 * 2 + vb) * 4 + m) * 64 + lane) * 16);
                const f32x4 g0 = *(const LAS f32x4*)(P + SC_G + (hd & 3) * 256 + (8 * m + 4 * hi) * 4), g1 = *(const LAS f32x4*)(P + SC_G + (hd & 3) * 256 + (32 + 8 * m + 4 * hi) * 4);
#pragma unroll
                for (int e = 0; e < 4; ++e) { n0[4 * m + e] = q0[e] + g0[e] * st0[4 * m + e]; n1[4 * m + e] = q1[e] + g1[e] * st1[4 * m + e]; }
            }
            bf16x8 sh[2][2], sl[2][2];
#pragma unroll
            for (int ks = 0; ks < 2; ++ks) {
                sh[0][ks] = pack_bf8(st0, 8 * ks); sh[1][ks] = pack_bf8(st1, 8 * ks);
                f32x16 d0, d1;
#pragma unroll
                for (int j = 0; j < 8; ++j) { const unsigned short h0 = (unsigned short)sh[0][ks][j], h1 = (unsigned short)sh[1][ks][j];
                    d0[j] = st0[8 * ks + j] - bf1(h0); d1[j] = st1[8 * ks + j] - bf1(h1); }
                sl[0][ks] = pack_bf8(d0, 0); sl[1][ks] = pack_bf8(d1, 0);
            }
            f32x16 z;
#pragma unroll
            for (int i = 0; i < 16; ++i) z[i] = 0.f;
#pragma unroll
            for (int kb = 0; kb < 2; ++kb)
#pragma unroll
                for (int ks = 0; ks < 2; ++ks) {
                    const bf16x8 c0 = *(const LAS bf16x8*)(P + SC_C + (((kb * 2 + 0) * 2 + ks) * 64 + lane) * 16), c1 = *(const LAS bf16x8*)(P + SC_C + (((kb * 2 + 1) * 2 + ks) * 64 + lane) * 16);
                    n0 = __builtin_amdgcn_mfma_f32_32x32x16_bf16(c0, sh[kb][ks], n0, 0, 0, 0); n0 = __builtin_amdgcn_mfma_f32_32x32x16_bf16(c0, sl[kb][ks], n0, 0, 0, 0);
                    n1 = __builtin_amdgcn_mfma_f32_32x32x16_bf16(c1, sh[kb][ks], n1, 0, 0, 0); n1 = __builtin_amdgcn_mfma_f32_32x32x16_bf16(c1, sl[kb][ks], n1, 0, 0, 0);
                    const v2u ra = *(const LAS v2u*)(P + SC_R + r32 * 128 + (32 * kb + 16 * ks + 4 * hi) * 2), rb2 = *(const LAS v2u*)(P + SC_R + r32 * 128 + (32 * kb + 16 * ks + 8 + 4 * hi) * 2);
                    v4u w; w.x = ra.x; w.y = ra.y; w.z = rb2.x; w.w = rb2.y; const bf16x8 rb = *reinterpret_cast<bf16x8*>(&w);
                    z = __builtin_amdgcn_mfma_f32_32x32x16_bf16(sh[kb][ks], rb, z, 0, 0, 0); z = __builtin_amdgcn_mfma_f32_32x32x16_bf16(sl[kb][ks], rb, z, 0, 0, 0);
                }
            const size_t tok = (size_t)b * S_ + (size_t)ch * 32 + r32;
#pragma unroll
            for (int m = 0; m < 4; ++m) { if (!dry) *(f32x4*)(zb + tok * 512 + hd * 64 + 32 * vb + 8 * m + 4 * hi) = (f32x4){z[4 * m], z[4 * m + 1], z[4 * m + 2], z[4 * m + 3]}; else asm volatile("" :: "v"(z[4 * m]), "v"(z[4 * m + 1]), "v"(z[4 * m + 2]), "v"(z[4 * m + 3])); }
            st0 = n0; st1 = n1;
        }
        __syncthreads();
    }
    asm volatile("s_waitcnt vmcnt(0)" ::: "memory"); __syncthreads();
    if (xb_thread0(wid)) { __builtin_amdgcn_fence(__ATOMIC_RELEASE, "agent"); asm volatile("s_waitcnt vmcnt(0)" ::: "memory"); (void)xb_add(done, 1u); }
}
__device__ __forceinline__ void s5_build_group(AP a, int l, int g, unsigned char* lds, const int tid) {
    float* PW = (float*)lds;
    float* BB = PW + 17 * 64 * 2;
    float* CC = BB + 64 * 16 * 2;
    float* KK = CC + 16 * 64 * 2;
    if (tid < 64) { const int p = tid; float ar, ai, lr, li; s5_ab(a, l, g, p, ar, ai, lr, li);
        const float den = lr * lr + li * li, nr = ar - 1.f, ni = ai, fre = (nr * lr + ni * li) / den, fim = (ni * lr - nr * li) / den;
        float pr = 1.f, pi = 0.f; asm volatile("" : "+v"(pr), "+v"(pi));
        for (int t = 0; t <= 16; ++t) { PW[(t * 64 + p) * 2] = pr; PW[(t * 64 + p) * 2 + 1] = pi; const float n0 = pr * ar - pi * ai, n1 = pr * ai + pi * ar; pr = n0; pi = n1; }
        const float* br = (const float*)a->in[I_S5BRE] + ((size_t)(l * 32 + g) * 64 + p) * 16; const float* bi = (const float*)a->in[I_S5BIM] + ((size_t)(l * 32 + g) * 64 + p) * 16;
        for (int c = 0; c < 16; ++c) { BB[(p * 16 + c) * 2] = fre * br[c] - fim * bi[c]; BB[(p * 16 + c) * 2 + 1] = fre * bi[c] + fim * br[c]; } }
    for (int i = tid; i < 1024; i += NTHR) { CC[i * 2] = ((const float*)a->in[I_S5CRE])[(size_t)(l * 32 + g) * 1024 + i]; CC[i * 2 + 1] = ((const float*)a->in[I_S5CIM])[(size_t)(l * 32 + g) * 1024 + i]; }
    __syncthreads();
    for (int e = tid; e < 4096; e += NTHR) { const int tau = e >> 8, c = (e >> 4) & 15, cp = e & 15; float acc = 0.f;
        for (int p = 0; p < 64; ++p) { const float cr = CC[(c * 64 + p) * 2], ci = CC[(c * 64 + p) * 2 + 1], pr = PW[(tau * 64 + p) * 2], pi = PW[(tau * 64 + p) * 2 + 1];
            const float xr = cr * pr - ci * pi, xi = cr * pi + ci * pr; acc += xr * BB[(p * 16 + cp) * 2] - xi * BB[(p * 16 + cp) * 2 + 1]; }
        KK[e] = acc; }
    __syncthreads();
    bf16* kz = (bf16*)(a->ws + WS_S5KZ) + (size_t)g * 256 * 384; bf16* w1 = (bf16*)(a->ws + WS_S5W1) + (size_t)g * 256 * 256;
    for (int i = tid; i < 256 * 48; i += NTHR) { const int n = i / 48, k0 = (i % 48) * 8, t = n >> 4, c = n & 15; float x[8];
#pragma unroll
        for (int j = 0; j < 8; ++j) { const int k = k0 + j;
            if (k < 256) { const int s = k >> 4, cp = k & 15; x[j] = (s <= t) ? KK[((t - s) * 16 + c) * 16 + cp] : 0.f; }
            else { const int p = (k - 256) & 63; const float cr = CC[(c * 64 + p) * 2], ci = CC[(c * 64 + p) * 2 + 1], pr = PW[((t + 1) * 64 + p) * 2], pi = PW[((t + 1) * 64 + p) * 2 + 1];
                x[j] = (k < 320) ? (cr * pr - ci * pi) : -(cr * pi + ci * pr); } }
        *(v4u*)(kz + (size_t)n * 384 + k0) = pack8(x); }
    for (int i = tid; i < 256 * 32; i += NTHR) { const int n = i >> 5, k0 = (i & 31) * 8; float x[8];
#pragma unroll
        for (int j = 0; j < 8; ++j) { const int k = k0 + j, s = k >> 4, cp = k & 15;
            if (n < 128) { const int p = n & 63; const float pr = PW[((15 - s) * 64 + p) * 2], pi = PW[((15 - s) * 64 + p) * 2 + 1], br = BB[(p * 16 + cp) * 2], bi = BB[(p * 16 + cp) * 2 + 1];
                x[j] = (n < 64) ? (pr * br - pi * bi) : (pr * bi + pi * br); } else x[j] = 0.f; }
        *(v4u*)(w1 + (size_t)n * 256 + k0) = pack8(x); }
    __syncthreads();
}

struct OneUnit { int pm, pn; __device__ bool next(int i, pg8::Unit& u) const { if (i) return false; u.pm = pm; u.pn = pn; return true; } };
struct EpiS5E {
    static constexpr bool PERM = false, AFTER_DRAIN = true;
    __device__ __forceinline__ void after(const f32x4 (&acc)[2][2][4][2], const pg8::Unit&, int wr, int wc, int fr, int fq, LAS unsigned char* lds) const {
        const int row0 = wr * 64 + fr, col0 = wc * 32 + 4 * fq;
#pragma unroll
        for (int ai = 0; ai < 2; ++ai)
#pragma unroll
            for (int m = 0; m < 4; ++m)
#pragma unroll
                for (int n = 0; n < 2; ++n) *(LAS f32x4*)(lds + ((row0 + ai * 128 + m * 16) * 128 + col0 + n * 16) * 4) = acc[ai][0][m][n];
    }
};
struct EpiS5Y {
    static constexpr bool PERM = true, AFTER_DRAIN = false;
    const bf16* proj; const float* dvec; bf16* gact; int g, tokbase;
    __device__ __forceinline__ void operator()(const f32x4 (&acc)[2][2][4][2], const pg8::Unit& u, int wr, int wc, int fr, int fq) const {
        int fr_ = fr, fq_ = fq; asm volatile("" : "+v"(fr_), "+v"(fq_));
        const int r0 = wr * 64 + fr_, c0 = wc * 32 + 8 * fq_;
        float dv[2][8];
#pragma unroll
        for (int bj = 0; bj < 2; ++bj) { const int cc = (c0 + bj * 128) & 15; *(f32x4*)&dv[bj][0] = *(const f32x4*)(dvec + g * 16 + cc); *(f32x4*)&dv[bj][4] = *(const f32x4*)(dvec + g * 16 + cc + 4); }
#pragma unroll
        for (int ai = 0; ai < 2; ++ai) {
            v4u ur[4][2];
#pragma unroll
            for (int m = 0; m < 4; ++m)
#pragma unroll
                for (int bj = 0; bj < 2; ++bj) { const int r = r0 + ai * 128 + m * 16, cl = c0 + bj * 128, t = cl >> 4, cc = cl & 15; const size_t tok = (size_t)tokbase + 16 * r + t;
                    ur[m][bj] = *(const v4u*)(proj + tok * LDP + C_US5 + g * 16 + cc); }
#pragma unroll
            for (int m = 0; m < 4; ++m) { const int r = r0 + ai * 128 + m * 16;
#pragma unroll
                for (int bj = 0; bj < 2; ++bj) { const int cl = c0 + bj * 128, t = cl >> 4, cc = cl & 15; const size_t tok = (size_t)tokbase + 16 * r + t;
                    float uu[8], y[8]; unpack8(ur[m][bj], uu);
#pragma unroll
                    for (int e = 0; e < 8; ++e) y[e] = gelu_fast(acc[ai][bj][m][e >> 2][e & 3] + dv[bj][e] * uu[e]);
                    *(v4u*)(gact + tok * 512 + g * 16 + cc) = pack8(y); } }
        }
    }
};
constexpr int S5_SG_OFF = 132096;
__device__ __forceinline__ void s5_step_g1(AP a, unsigned char* lds, int u, const int tid) {
    pg8::Gemm gm{(const bf16*)(a->ws + WS_ACAT), (const bf16*)(a->ws + WS_S5W1), 32768, 8192, 256, 384, 256}; OneUnit S{u, u >> 2};
    EpiS5E E{}; pg8::gemm_phase<EpiS5E, OneUnit>((LAS unsigned char*)lds, gm, S, E, tid);
    __syncthreads();
}
__device__ __forceinline__ void s5_step_scan(AP a, int l, unsigned char* lds, int u, const int tid) {
    const int g = u >> 2;
    const int seg = tid >> 6, p = tid & 63; float ar, ai, lr, li; s5_ab(a, l, g, p, ar, ai, lr, li);
#pragma unroll
    for (int i = 0; i < 4; ++i) { const float n0 = ar * ar - ai * ai, n1 = 2.f * ar * ai; ar = n0; ai = n1; }
    const float* E = (const float*)lds + (seg * 32) * 128;
    float hr = 0.f, hi = 0.f;
#pragma unroll 8
    for (int r = 0; r < 32; ++r) { const float er = E[r * 128 + p], ei = E[r * 128 + 64 + p]; const float n0 = ar * hr - ai * hi + er, n1 = ar * hi + ai * hr + ei; hr = n0; hi = n1; }
    float* SG = (float*)(lds + S5_SG_OFF);
    SG[(seg * 64 + p) * 2] = hr; SG[(seg * 64 + p) * 2 + 1] = hi;
    __syncthreads();
    float br = ar, bi = ai;
#pragma unroll
    for (int i = 0; i < 5; ++i) { const float n0 = br * br - bi * bi, n1 = 2.f * br * bi; br = n0; bi = n1; }
    hr = 0.f; hi = 0.f;
    for (int j = 0; j < seg; ++j) { const float sr = SG[(j * 64 + p) * 2], si = SG[(j * 64 + p) * 2 + 1]; const float n0 = br * hr - bi * hi + sr, n1 = br * hi + bi * hr + si; hr = n0; hi = n1; }
    bf16* ac = (bf16*)(a->ws + WS_ACAT) + ((size_t)u * 256 + seg * 32) * 384 + 256;
#pragma unroll 8
    for (int r = 0; r < 32; ++r) { ac[r * 384 + p] = f2bf(hr); ac[r * 384 + 64 + p] = f2bf(hi);
        const float er = E[r * 128 + p], ei = E[r * 128 + 64 + p]; const float n0 = ar * hr - ai * hi + er, n1 = ar * hi + ai * hr + ei; hr = n0; hi = n1; }
    asm volatile("s_waitcnt vmcnt(0)" ::: "memory"); __syncthreads();
}
__device__ __forceinline__ void s5_step_g2(AP a, int l, unsigned char* lds, int u, const int tid) {
    const int g = u >> 2, b = u & 3;
    pg8::Gemm gm{(const bf16*)(a->ws + WS_ACAT), (const bf16*)(a->ws + WS_S5KZ), 32768, 8192, 384, 384, 384}; OneUnit S{u, g};
    EpiS5Y E{(const bf16*)(a->ws + WS_PROJ), (const float*)a->in[I_S5D] + l * 512, (bf16*)(a->ws + WS_GACT), g, b * S_};
    pg8::gemm_phase<EpiS5Y, OneUnit>((LAS unsigned char*)lds, gm, S, E, tid);
}
__device__ __forceinline__ void phase_rwkv_finish(AP a, int l, int m_lo, int m_hi, int wave, int lane) {
    const float* rwo = (const float*)(a->ws + WS_RWO);
    const bf16* rwv = (const bf16*)(a->ws + WS_RW) + 2 * RW_STRIDE; const bf16* proj = (const bf16*)(a->ws + WS_PROJ); bf16* mixed = (bf16*)(a->ws + WS_MIXED);
    const float* lg = (const float*)a->in[I_LNG] + l * 512 + lane * 8; const float* lb = (const float*)a->in[I_LNB] + l * 512 + lane * 8;
    const f32x4 g0 = *(const f32x4*)lg, g1 = *(const f32x4*)(lg + 4), b0 = *(const f32x4*)lb, b1 = *(const f32x4*)(lb + 4);
    const float* rkp = (const float*)a->in[I_RK] + l * 512 + lane * 8; const f32x4 rk0 = *(const f32x4*)rkp, rk1 = *(const f32x4*)(rkp + 4);
    constexpr int FB = 4;
    for (int m0 = m_lo + wave; m0 < m_hi; m0 += NWAVES * FB) {
        f32x4 ra[FB][2], za[FB][2]; v4u rr_[FB], kp_[FB], vv_[FB], gt_[FB];
#pragma unroll
        for (int t = 0; t < FB; ++t) { const int m = m0 + t * NWAVES; if (m < m_hi) { const size_t o = (size_t)m * 512 + lane * 8;
            ra[t][0] = *(const f32x4*)(rwo + o); ra[t][1] = *(const f32x4*)(rwo + o + 4);
            const float* zbp = (const float*)(a->ws + WS_ZB) + o; za[t][0] = *(const f32x4*)zbp; za[t][1] = *(const f32x4*)(zbp + 4);
            rr_[t] = *(const v4u*)(rwv - 2 * RW_STRIDE + o); kp_[t] = *(const v4u*)(rwv - RW_STRIDE + o); vv_[t] = *(const v4u*)(rwv + o);
            gt_[t] = *(const v4u*)(proj + (size_t)m * LDP + C_GATE + 1024 + lane * 8); } }
#pragma unroll
        for (int t = 0; t < FB; ++t) { const int m = m0 + t * NWAVES; if (m < m_hi) {
            const f32x4 o0 = ra[t][0] + za[t][0], o1 = ra[t][1] + za[t][1];
            const float mean = red8((o0.x + o0.y + o0.z + o0.w) + (o1.x + o1.y + o1.z + o1.w)) * (1.f / 64.f);
            const f32x4 d0 = o0 - mean, d1 = o1 - mean;
            const float var = red8((d0.x * d0.x + d0.y * d0.y + d0.z * d0.z + d0.w * d0.w) + (d1.x * d1.x + d1.y * d1.y + d1.z * d1.z + d1.w * d1.w)) * (1.f / 64.f);
            const float rstd = 1.f / sqrtf(var + 64e-5f);
            float v[8], gt[8], y[8], rr[8], kp[8];
            unpack8(rr_[t], rr); unpack8(kp_[t], kp);
            float bn = 0.f;
#pragma unroll
            for (int e = 0; e < 8; ++e) bn += rr[e] * kp[e] * (e < 4 ? rk0[e & 3] : rk1[e & 3]);
            bn = red8(bn);
            unpack8(vv_[t], v); unpack8(gt_[t], gt);
#pragma unroll
            for (int e = 0; e < 4; ++e) { y[e] = (d0[e] * rstd * g0[e] + b0[e] + bn * v[e]) * siluf_(gt[e]); y[4 + e] = (d1[e] * rstd * g1[e] + b1[e] + bn * v[4 + e]) * siluf_(gt[4 + e]); }
            *(v4u*)(mixed + (size_t)m * D_ + 1024 + lane * 8) = pack8(y); } }
    }
}

__device__ __forceinline__ int q_pop(unsigned* head, volatile LAS unsigned* slot, int wave_idx) {
    __syncthreads();
    if (xb_thread0(wave_idx)) *slot = __hip_atomic_fetch_add(head, 1u, __ATOMIC_RELAXED, __HIP_MEMORY_SCOPE_AGENT);
    __syncthreads();
    return (int)*slot;
}
struct QTicket { unsigned nxt; };
__device__ __forceinline__ QTicket q_first(unsigned* head, int wave_idx) { QTicket t; t.nxt = 0u;
    if (xb_thread0(wave_idx)) t.nxt = __hip_atomic_fetch_add(head, 1u, __ATOMIC_RELAXED, __HIP_MEMORY_SCOPE_AGENT);
    return t; }
__device__ __forceinline__ int q_next(QTicket& t, unsigned* head, unsigned limit, volatile LAS unsigned* slot, int wave_idx) {
    __syncthreads();
    if (xb_thread0(wave_idx)) { const unsigned cur = t.nxt; *slot = cur; if (cur < limit) t.nxt = __hip_atomic_fetch_add(head, 1u, __ATOMIC_RELAXED, __HIP_MEMORY_SCOPE_AGENT); }
    __syncthreads();
    return (int)*slot;
}
constexpr int PH_PER_L = 5, N_PHASES = 1 + L_ * PH_PER_L + 1;
template <int PATT> __device__ __forceinline__ void fwd_body(const Args& args0) {
    extern __shared__ __attribute__((aligned(16))) unsigned char lds[];
    const int tid0 = threadIdx.x;
    const int wave_s = __builtin_amdgcn_readfirstlane(tid0 >> 6);
    const int G = gridDim.x, bx = blockIdx.x;
#define SITE() AP args; { unsigned long long kp_ = (unsigned long long)__builtin_amdgcn_kernarg_segment_ptr(); asm volatile("" : "+s"(kp_)); args = (AP)kp_; } int tid; asm volatile("v_mbcnt_lo_u32_b32 %0, -1, 0\n\tv_mbcnt_hi_u32_b32 %0, -1, %0\n\tv_lshl_add_u32 %0, %1, 6, %0" : "=&v"(tid) : "s"(wave_s));     const int lane = tid & 63, wave = __builtin_amdgcn_readfirstlane(tid >> 6); const int gw = bx * NWAVES + wave, NGW = G * NWAVES; (void)lane; (void)gw; (void)NGW
    volatile LAS unsigned* MISC = (volatile LAS unsigned*)((LAS unsigned char*)lds + MISC_OFF);
    if (tid0 < 32) MISC[tid0] = 0u;
    __syncthreads();
    unsigned* ctl = (unsigned*)(args0.ws + WS_CTL);
    const bool one_launch = (args0.ph_hi - args0.ph_lo) > 1;
    XcdBarrier bar; bar.bar = ctl + CW_BAR; bar.x = 0; bar.st = nullptr; bar.wave = wave_s;
    if (one_launch) bar = xcd_barrier_post(ctl + CW_BAR, MISC + 8, wave_s);
    const int lo = args0.ph_lo, hi = args0.ph_hi;
#define IN(k) (lo <= (k) && (k) < hi)
#define SEAM(k) do { if (IN(k) && IN((k) + 1)) xcd_barrier(bar); } while (0)

    if (IN(0)) { SITE(); phase_convert(args, lds, gw, NGW, wave, lane); }
    SEAM(0);
    for (int l = 0; l < L_; ++l) {
        const int p0 = l * PH_PER_L;
        if (IN(p0 + 1)) { SITE();
            const bf16* xl = (const bf16*)args->out + (size_t)(l & 1) * M_ * D_;
            int bxl = bx; asm volatile("" : "+s"(bxl));
            pg8::Gemm g{xl, (const bf16*)(args->ws + WS_WIN) + (size_t)l * LDP * D_, M_, LDP, D_, D_, D_}; pg8::StaticOrder S; S.init(M_, LDP, G, bxl);
            const float* ssp = (const float*)(args->ws + WS_SSP); LAS float* RS = (LAS float*)((LAS unsigned char*)lds + RSTD_OFF);
            pg8::Unit u0; int pm_tab = -1;
            if (S.next(0, u0)) { pm_tab = u0.pm;
                if (tid < 256) { const float* sp = ssp + (size_t)(pm_tab * 256 + tid) * 32; float tot = 0.f;
#pragma unroll
                    for (int q = 0; q < 8; ++q) { const f32x4 p4 = *(const f32x4*)(sp + 4 * q); tot += (p4.x + p4.y) + (p4.z + p4.w); }
                    RS[tid] = 1.f / sqrtf(tot * (1.f / D_) + NORM_EPS); } }
            __syncthreads();
            EpiBf16Rs E{(bf16*)(args->ws + WS_PROJ), LDP, ssp, RS, pm_tab};
            pg8::gemm_phase<EpiBf16Rs, pg8::StaticOrder, (PATT == 11 ? 1 : (PATT == 12 ? 2 : 0))>((LAS unsigned char*)lds, g, S, E, tid);
        }
        if (IN(p0 + 1)) { SITE();
            constexpr int NU = (M_ / 256) * (LDP / 256); const int first_idle = NU % G;
            __syncthreads();
            if (l == 0 && bx >= first_idle) for (int g = bx - first_idle; g < 32; g += G - first_idle) s5_build_group(args, l, g, lds, tid);
        }
        SEAM(p0 + 1);
        if (IN(p0 + 2)) { { SITE(); phase_prep(args, l, gw, NGW, lane, args->rep == 0); } }
        SEAM(p0 + 2);
        if (IN(p0 + 3)) {
            { SITE();
              for (int ui = bx; ui < (M_ / 256) * 4; ui += G) { SITE();
                  pg8::Gemm g{(const bf16*)(args->ws + WS_WLA), (const bf16*)(args->ws + WS_LBT) + (size_t)l * 1024 * 256, M_, 1024, 256, 256, 256}; OneUnit S{ui >> 2, ui & 3};
                  EpiLora E{args, l, args->rep != 0};
                  pg8::gemm_phase<EpiLora, OneUnit>((LAS unsigned char*)lds, g, S, E, tid); __syncthreads(); }
              asm volatile("s_waitcnt vmcnt(0)" ::: "memory"); __syncthreads();
              if (xb_thread0(wave_s)) { __builtin_amdgcn_fence(__ATOMIC_RELEASE, "agent"); asm volatile("s_waitcnt vmcnt(0)" ::: "memory"); (void)xb_add(ctl + CW_Q + 64 * (l * 32 + 4 * args0.rep) + 16, 1u); } }
            { SITE(); unsigned* q1 = ctl + CW_Q + 64 * (l * 32 + 4 * args0.rep) + 64 * 0 + 32;
              for (;;) { const int u = q_pop(q1, MISC + 16, wave_s); if (u >= 128) break; { SITE(); s5_step_g1(args, lds, u, tid); } { SITE(); s5_step_scan(args, l, lds, u, tid); } { SITE(); s5_step_g2(args, l, lds, u, tid); } } }
            { SITE(); pg8::Gemm g{(const bf16*)(args->ws + WS_CQN), (const bf16*)(args->ws + WS_WUQ) + (size_t)l * NQ * 512, M_, NQ, 512, 512, 512}; pg8::StaticOrder S; S.init(M_, NQ, G, bx);
              EpiBf16 E{(bf16*)(args->ws + WS_QM), NQ}; pg8::gemm_phase<EpiBf16, pg8::StaticOrder>((LAS unsigned char*)lds, g, S, E, tid); }
            { SITE(); pg8::Gemm g{(const bf16*)(args->ws + WS_CKVN), (const bf16*)(args->ws + WS_WUKV) + (size_t)l * NKV * 256, M_, NKV, 256, 256, 256}; pg8::StaticOrder S; S.init(M_, NKV, G, bx);
              EpiBf16 E{(bf16*)(args->ws + WS_KVM), NKV}; pg8::gemm_phase<EpiBf16, pg8::StaticOrder>((LAS unsigned char*)lds, g, S, E, tid); }

            { SITE();
              unsigned* dn = ctl + CW_Q + 64 * (l * 32 + 4 * args0.rep) + 16;
              if (xb_thread0(wave_s)) { XB_SPIN(xb_ld(dn) < (unsigned)G, ctl + CW_BAR); __builtin_amdgcn_fence(__ATOMIC_ACQUIRE, "agent"); asm volatile("s_waitcnt vmcnt(0)" ::: "memory"); }
              __syncthreads(); }
            { SITE(); unsigned* qc = ctl + CW_Q + 64 * (l * 32 + 4 * args0.rep) + 64 * 2 + 32;
              QTicket qt1_ = q_first(qc, wave_s); int u = q_next(qt1_, qc, (unsigned)(B_ * 128 * 4), MISC + 16, wave_s); CkPre pre_; pre_.r = pre_.k = pre_.v = pre_.kk = pre_.al = pre_.ee = (v4u){0u, 0u, 0u, 0u}; if (u < B_ * 128 * 4) ck_prefetch(args, u, tid, pre_);
              while (u < B_ * 128 * 4) u = rwkv_chunk_unit(args, l, lds, u, tid, args->rep != 0, pre_, qt1_, qc, (unsigned)(B_ * 128 * 4), MISC + 16, wave_s); }
        }
        SEAM(p0 + 3);
        if (IN(p0 + 4)) {
            const int rep = args0.rep; unsigned* qh = ctl + CW_Q + 64 * (l * 32 + 4 * rep);
            if (rep == 0 || rep == 1 || rep == 4) { SITE(); QTicket qt2_ = q_first(qh + 0 * 64, wave_s); for (;;) { const int u = q_next(qt2_, qh + 0 * 64, (unsigned)(32), MISC + 16, wave_s); if (u >= 32) break; rwkv_scan_unit(args, lds, u, tid, rep != 0, qh + 48); } }
            for (int pass = 0; pass < 2; ++pass) {
            if (((bx + pass) & 1) == 0) {
            if (rep == 0 || rep == 2 || rep == 4) { SITE(); QTicket qt3_ = q_first(qh + 1 * 64, wave_s); for (;;) { const int u = q_next(qt3_, qh + 1 * 64, (unsigned)(256), MISC + 16, wave_s); if (u >= 256) break;
                attn_unit<0>(args, l, lds, (u & 15) >> 2, u & 3, 15 - (u >> 4), 0.f, 0.f, tid); } }
            } else {
            if (rep == 0 || rep == 3 || rep == 4) {   SITE(); const float* lq1 = (const float*)args->in[I_LQ1] + l * 64; const float* lk1 = (const float*)args->in[I_LK1] + l * 64;
                const float* lq2 = (const float*)args->in[I_LQ2] + l * 64; const float* lk2 = (const float*)args->in[I_LK2] + l * 64;
                const float lam_init = 0.8f - 0.6f * expf(-0.3f * (float)l);
                const float lam = expf(wave_sum_fast(lq1[lane] * lk1[lane])) - expf(wave_sum_fast(lq2[lane] * lk2[lane])) + lam_init;
                QTicket qt4_ = q_first(qh + 2 * 64, wave_s); for (;;) { const int u = q_next(qt4_, qh + 2 * 64, (unsigned)(512), MISC + 16, wave_s); if (u >= 512) break;
                    const int bb_ = (u & 15) >> 2, hh_ = u & 3, qb_ = 31 - (u >> 4);
                    attn_unit<1, PATT>(args, l, lds, bb_, hh_, qb_, lam, lam_init, tid); }
            }
            }
            }
            if (rep == 0 || rep == 4) {
                {   SITE();
                    unsigned* qg = qh + 3 * 64; QTicket qt5_ = q_first(qg, wave_s);
                    for (;;) { const int u = q_next(qt5_, qg, (unsigned)(128), MISC + 16, wave_s); if (u >= 128) break;
                        SITE(); pg8::Gemm g{(const bf16*)(args->ws + WS_GACT), (const bf16*)(args->ws + WS_WGLU) + (size_t)l * 512 * 512, M_, 512, 512, 512, 512}; OneUnit S{u >> 1, u & 1};
                        EpiGlu E{(const bf16*)(args->ws + WS_GACT), (const float*)args->in[I_S5BGLU] + l * 512, (const bf16*)(args->ws + WS_PROJ), (bf16*)(args->ws + WS_MIXED)};
                        pg8::gemm_phase<EpiGlu, OneUnit>((LAS unsigned char*)lds, g, S, E, tid); __syncthreads(); } }
                if (l + 1 < L_) { SITE();
                    unsigned* qb = qh + 64 + 32; QTicket qt7_ = q_first(qb, wave_s);
                    for (;;) { const int u = q_next(qt7_, qb, (unsigned)(32), MISC + 16, wave_s); if (u >= 32) break; s5_build_group(args, l + 1, u, lds, tid); } }
                {   SITE();
                    unsigned* dn = qh + 48;
                    if (xb_thread0(wave_s)) { XB_SPIN(xb_ld(dn) < 32u, ctl + CW_BAR); __builtin_amdgcn_fence(__ATOMIC_ACQUIRE, "agent"); asm volatile("s_waitcnt vmcnt(0)" ::: "memory"); }
                    __syncthreads();
                    unsigned* qf = qh + 3 * 64 + 32; QTicket qt6_ = q_first(qf, wave_s);
                    for (;;) { const int u = q_next(qt6_, qf, (unsigned)(M_ / 64), MISC + 16, wave_s); if (u >= M_ / 64) break; phase_rwkv_finish(args, l, u * 64, u * 64 + 64, wave, lane); } }
            }
        }
        SEAM(p0 + 4);
        if (IN(p0 + 5)) { SITE();
            pg8::Gemm g{(const bf16*)(args->ws + WS_MIXED), (const bf16*)(args->ws + WS_WOUT) + (size_t)l * D_ * D_, M_, D_, D_, D_, D_}; pg8::StaticOrder S; S.init(M_, D_, G, bx);
            const bf16* xl = (const bf16*)args->out + (size_t)(l & 1) * M_ * D_; bf16* xn = (bf16*)args->out + (size_t)((l + 1) & 1) * M_ * D_;
            EpiResidX E{(l == 0) ? (const float*)args->in[I_X] : nullptr, xl, xn, (l == L_ - 1) ? (float*)(args->ws + WS_PROJ) : nullptr, (float*)(args->ws + WS_SSP)};
            if (args->rep) { E.xout_b = (bf16*)(args->ws + WS_PROJ + 128 * MiB); E.xout_f = nullptr; E.ssn = (float*)(args->ws + WS_CKVN); }
            pg8::gemm_phase<EpiResidX, pg8::StaticOrder>((LAS unsigned char*)lds, g, S, E, tid);
        }
        SEAM(p0 + 5);
    }
    if (IN(N_PHASES - 1)) { SITE(); phase_rmsnorm<true>((const float*)(args->ws + WS_PROJ), (const float*)args->in[I_FNG], args->out, gw, NGW, lane); }
#undef IN
#undef SEAM
}

__global__ void __launch_bounds__(NTHR, 2) fwd(Args args0) { fwd_body<0>(args0); }
#if defined(PROBE_ATT)
__global__ void __launch_bounds__(NTHR, 2) fwd_probe(Args args0) { fwd_body<PROBE_ATT>(args0); }
#endif
#ifndef MK_ONE_LAUNCH
#define MK_ONE_LAUNCH 1
#endif
extern "C" void kernel_launch(void* const* d_in, const int* in_sizes, int n_in, void* d_out, int out_size, void* d_ws, size_t ws_size, hipStream_t stream) {
    static int grid = 0;
    if (grid == 0) {
        if (n_in != N_INPUTS || out_size != M_ * D_ || ws_size < WS_END2) { fprintf(stderr, "kernel_launch: unexpected shapes (n_in %d, out %d, ws %zu < %zu)\n", n_in, out_size, ws_size, (size_t)WS_END); grid = -1; return; }
        int dev = 0, cus = 0, per_cu = 0;
        if (hipGetDevice(&dev) != hipSuccess || hipDeviceGetAttribute(&cus, hipDeviceAttributeMultiprocessorCount, dev) != hipSuccess) { grid = -1; return; }
#if defined(PROBE_ATT)
        (void)hipFuncSetAttribute((const void*)fwd_probe, hipFuncAttributeMaxDynamicSharedMemorySize, LDS_BYTES);
#endif
        if (hipFuncSetAttribute((const void*)fwd, hipFuncAttributeMaxDynamicSharedMemorySize, LDS_BYTES) != hipSuccess) { fprintf(stderr, "kernel_launch: hipFuncSetAttribute failed\n"); grid = -1; return; }
        if (hipOccupancyMaxActiveBlocksPerMultiprocessor(&per_cu, (const void*)fwd, NTHR, LDS_BYTES) != hipSuccess || per_cu < 1) { fprintf(stderr, "kernel_launch: occupancy query says %d\n", per_cu); }
        (void)hipGetLastError();
        grid = cus;
    }
    if (grid < 0) return;
    (void)hipMemsetAsync((char*)d_ws + WS_CTL, 0, CTL_ZERO_BYTES, stream);
    Args a{};
    for (int i = 0; i < N_INPUTS; ++i) a.in[i] = d_in[i];
    a.out = (float*)d_out; a.ws = (unsigned char*)d_ws;
#if defined(PROBE_K)
#define PROBE_THIS(p) ((PROBE_K == 100) ? ((p) == 0) : (PROBE_K == 101) ? ((p) == N_PHASES - 1) : ((p) >= 1 && (p) < N_PHASES - 1 && ((p) - 1) % PH_PER_L == PROBE_K))
    for (int p = 0; p < N_PHASES; ++p) { a.ph_lo = p; a.ph_hi = p + 1;
#if defined(PROBE_BEFORE)
        if (PROBE_THIS(p)) for (int r = 1; r <= PROBE_N; ++r) { a.rep = PROBE_REP;
#if defined(PROBE_ATT)
            hipLaunchKernelGGL(fwd_probe, dim3(grid), dim3(NTHR), LDS_BYTES, stream, a);
#else
            hipLaunchKernelGGL(fwd, dim3(grid), dim3(NTHR), LDS_BYTES, stream, a);
#endif
        }
#endif
        a.rep = 0; hipLaunchKernelGGL(fwd, dim3(grid), dim3(NTHR), LDS_BYTES, stream, a);
#if !defined(PROBE_BEFORE)
        if (PROBE_THIS(p)) for (int r = 1; r <= PROBE_N; ++r) { a.rep = PROBE_REP; hipLaunchKernelGGL(fwd, dim3(grid), dim3(NTHR), LDS_BYTES, stream, a); }
#endif
    }
#elif MK_ONE_LAUNCH
    a.ph_lo = 0; a.ph_hi = N_PHASES;
    hipLaunchKernelGGL(fwd, dim3(grid), dim3(NTHR), LDS_BYTES, stream, a);
#else
    for (int p = 0; p < N_PHASES; ++p) { a.ph_lo = p; a.ph_hi = p + 1; hipLaunchKernelGGL(fwd, dim3(grid), dim3(NTHR), LDS_BYTES, stream, a); }
#endif
}
```

```cpp
#include <hip/hip_runtime.h>
#include <cstdio>
#include <cstdint>

namespace pg8 {
#define PG8_LAS __attribute__((address_space(3)))
typedef unsigned short bf16_t;
typedef short bf16x8 __attribute__((ext_vector_type(8)));
typedef float f32x4 __attribute__((ext_vector_type(4)));
typedef unsigned u32x4 __attribute__((ext_vector_type(4)));
constexpr int BM = 256, BK = 64, HALF = 128, HTB = HALF * BK * 2, STAGE_BYTES = 8 * HTB, NXCD = 8, WGM = 8;

__host__ __device__ __forceinline__ int lds_byte(int r, int c) { const int st = (r >> 4) * 2 + (c >> 5), rr = r & 15, cc = c & 31, ob = rr * 64 + cc * 2; return st * 1024 + (ob ^ (((ob >> 9) & 1) << 5)); }
__host__ __device__ __forceinline__ void stage_rc(int b, int& R, int& C) { const int st = b / 1024, sb = b % 1024, swz = sb ^ (((sb >> 9) & 1) << 5); R = (st >> 1) * 16 + swz / 64; C = (st & 1) * 32 + (swz % 64) / 2; }
__host__ __device__ __forceinline__ int perm32(int rho) { const int n = rho >> 4, i = rho & 15; return 8 * (i >> 2) + 4 * n + (i & 3); }

struct Unit { int pm, pn; };
struct Gemm { const bf16_t* A; const bf16_t* Bt; int M, N, K, lda, ldb; };

struct StaticOrder {
    int nM, nN, nwg, G, c;
    __host__ __device__ void init(int M, int N, int G_, int c_) { nM = M / BM; nN = N / BM; nwg = nM * nN; G = G_; c = c_; }
    __host__ __device__ bool next(int i, Unit& u) const {
        const long L = (long)i * G + c; if (L >= nwg) return false;
        int wgid = (int)L; { const int q = nwg / NXCD, r = nwg % NXCD, xcd = wgid % NXCD, off = wgid / NXCD; wgid = (xcd < r ? xcd * (q + 1) : r * (q + 1) + (xcd - r) * q) + off; }
        const int nig = WGM * nN, gid = wgid / nig, fm = gid * WGM, gsz = (nM - fm) < WGM ? (nM - fm) : WGM;
        u.pm = fm + ((wgid % nig) % gsz); u.pn = (wgid % nig) / gsz; return true;
    }
};
typedef __bf16 bf16n2 __attribute__((ext_vector_type(2)));
typedef float f32n2 __attribute__((ext_vector_type(2)));
__device__ __forceinline__ unsigned cvt_pk_bf16(float lo, float hi) { const bf16n2 r = __builtin_convertvector((f32n2){lo, hi}, bf16n2); return __builtin_bit_cast(unsigned, r); }

template <class Epi, class Sched, int PV = 0>
__device__ __forceinline__ void gemm_phase(PG8_LAS unsigned char* lds, const Gemm g, const Sched& S, const Epi& E, const int tid) {
    const int wid = __builtin_amdgcn_readfirstlane(tid >> 6), lane = tid & 63, wr = wid >> 2, wc = wid & 3, fr = lane & 15, fq = lane >> 4;
    const int K = g.K, nt = K / BK;
    unsigned voffA[2], voffB[2];
#pragma unroll
    for (int i = 0; i < 2; ++i) { int R, C; stage_rc(tid * 16 + i * 8192, R, C); const int Rb = Epi::PERM ? ((R & ~31) + perm32(R & 31)) : R;
        voffA[i] = (unsigned)(R * g.lda + C) * 2u; voffB[i] = (unsigned)(Rb * g.ldb + C) * 2u; }
    const size_t kstep = (PV == 1) ? (size_t)0 : (size_t)(BK * 2);
    const size_t hstepA = (size_t)HALF * g.lda * 2, hstepB = (size_t)HALF * g.ldb * 2;
    const size_t tstepA = 2 * hstepA, tstepB = 2 * hstepB;
    const unsigned ldsw = (unsigned)wid * 1024u;
    const int aoff = lds_byte(wr * 64 + fr, fq * 8), boff = lds_byte(wc * 32 + fr, fq * 8);
#define PG8_SA(b, h) (((b) * 2 + (h)) * HTB)
#define PG8_SB(b, h) ((4 + (b) * 2 + (h)) * HTB)
#define PG8_STAGE(bufoff, gbase, voff) do { _Pragma("unroll") for (int _i = 0; _i < 2; ++_i) \
        __builtin_amdgcn_global_load_lds((const unsigned*)((const char*)(gbase) + (voff)[_i]), (PG8_LAS unsigned*)(lds + (bufoff) + ldsw + _i * 8192), 16, 0, 0); } while (0)
#define PG8_LDA(dst, b, h) do { _Pragma("unroll") for (int m = 0; m < 4; ++m) _Pragma("unroll") for (int k = 0; k < 2; ++k) dst[m][k] = *(const PG8_LAS bf16x8*)(lds + PG8_SA(b, h) + aoff + m * 2048 + k * 1024); } while (0)
#define PG8_LDB(dst, b, h) do { _Pragma("unroll") for (int n = 0; n < 2; ++n) _Pragma("unroll") for (int k = 0; k < 2; ++k) dst[n][k] = *(const PG8_LAS bf16x8*)(lds + PG8_SB(b, h) + boff + n * 2048 + k * 1024); } while (0)
#define PG8_MMA(ai, bj, At, Bt) do { __builtin_amdgcn_s_setprio(1); _Pragma("unroll") for (int m = 0; m < 4; ++m) _Pragma("unroll") for (int n = 0; n < 2; ++n) _Pragma("unroll") for (int k = 0; k < 2; ++k) \
        acc[ai][bj][m][n] = __builtin_amdgcn_mfma_f32_16x16x32_bf16(Bt[n][k], At[m][k], acc[ai][bj][m][n], 0, 0, 0); __builtin_amdgcn_s_setprio(0); } while (0)
#define PG8_WAIT_V(n) asm volatile("s_waitcnt vmcnt(" #n ")" ::: "memory")
#define PG8_WAIT_L(n) asm volatile("s_waitcnt lgkmcnt(" #n ")" ::: "memory")
#define PG8_BAR __builtin_amdgcn_s_barrier()
#define PG8_SCHED __builtin_amdgcn_sched_barrier(0)
    Unit cur, nxt; int ui = 0;
    if (!S.next(0, cur)) return;
    f32x4 acc[2][2][4][2];
#pragma unroll
    for (int a = 0; a < 2; ++a)
#pragma unroll
        for (int b = 0; b < 2; ++b)
#pragma unroll
            for (int m = 0; m < 4; ++m)
#pragma unroll
                for (int n = 0; n < 2; ++n) acc[a][b][m][n] = (f32x4){0.f, 0.f, 0.f, 0.f};
    bf16x8 At[4][2], B0[2][2], B1[2][2];
    const char* cA = (const char*)g.A + (size_t)cur.pm * tstepA; const char* cB = (const char*)g.Bt + (size_t)cur.pn * tstepB;
    PG8_STAGE(PG8_SB(0, 0), cB, voffB); PG8_STAGE(PG8_SA(0, 0), cA, voffA); PG8_STAGE(PG8_SB(0, 1), cB + hstepB, voffB); PG8_STAGE(PG8_SA(0, 1), cA + hstepA, voffA);
    if (wr == 1) PG8_BAR;
    PG8_WAIT_V(4); PG8_BAR;
    PG8_STAGE(PG8_SB(1, 0), cB + kstep, voffB); PG8_STAGE(PG8_SA(1, 0), cA + kstep, voffA); PG8_STAGE(PG8_SB(1, 1), cB + hstepB + kstep, voffB);
    PG8_WAIT_V(6); PG8_BAR;
    for (;;) {
        const bool has_next = S.next(ui + 1, nxt);
        const char* nA = has_next ? (const char*)g.A + (size_t)nxt.pm * tstepA : cA; const char* nB = has_next ? (const char*)g.Bt + (size_t)nxt.pn * tstepB : cB;
        for (int t = 0; t < nt; t += 2) {
            const bool last = (t == nt - 2);
            const char* a1 = cA + (size_t)(t + 1) * kstep;
            const char* a2 = last ? nA : cA + (size_t)(t + 2) * kstep; const char* b2 = last ? nB : cB + (size_t)(t + 2) * kstep;
            const char* a3 = a2 + kstep; const char* b3 = b2 + kstep;
            PG8_LDB(B0, 0, 0); PG8_SCHED; PG8_LDA(At, 0, 0); PG8_STAGE(PG8_SA(1, 1), a1 + hstepA, voffA);
            PG8_WAIT_L(8); PG8_BAR; PG8_WAIT_L(0); PG8_MMA(0, 0, At, B0); PG8_BAR; PG8_SCHED;
            PG8_LDB(B1, 0, 1); PG8_STAGE(PG8_SB(0, 0), b2, voffB);
            PG8_BAR; PG8_WAIT_L(0); PG8_MMA(0, 1, At, B1); PG8_BAR;
            PG8_LDA(At, 0, 1); PG8_STAGE(PG8_SA(0, 0), a2, voffA);
            PG8_BAR; PG8_WAIT_L(0); PG8_MMA(1, 0, At, B0); PG8_BAR; PG8_SCHED;
            PG8_STAGE(PG8_SB(0, 1), b2 + hstepB, voffB);
            PG8_WAIT_V(6); PG8_BAR; PG8_MMA(1, 1, At, B1); PG8_BAR;
            PG8_LDB(B0, 1, 0); PG8_SCHED; PG8_LDA(At, 1, 0); PG8_STAGE(PG8_SA(0, 1), a2 + hstepA, voffA);
            PG8_WAIT_L(8); PG8_BAR; PG8_WAIT_L(0); PG8_MMA(0, 0, At, B0); PG8_BAR; PG8_SCHED;
            PG8_LDB(B1, 1, 1); PG8_STAGE(PG8_SB(1, 0), b3, voffB);
            PG8_BAR; PG8_WAIT_L(0); PG8_MMA(0, 1, At, B1); PG8_BAR;
            PG8_LDA(At, 1, 1); PG8_STAGE(PG8_SA(1, 0), a3, voffA);
            PG8_BAR; PG8_WAIT_L(0); PG8_MMA(1, 0, At, B0); PG8_BAR; PG8_SCHED;
            PG8_STAGE(PG8_SB(1, 1), b3 + hstepB, voffB);
            PG8_WAIT_V(6); PG8_BAR; PG8_MMA(1, 1, At, B1); PG8_BAR;
        }
        if constexpr (!Epi::AFTER_DRAIN && PV != 2) E(acc, cur, wr, wc, fr, fq);
        if constexpr (PV == 2) { _Pragma("unroll") for (int a_ = 0; a_ < 2; ++a_) _Pragma("unroll") for (int b_ = 0; b_ < 2; ++b_) _Pragma("unroll") for (int m_ = 0; m_ < 4; ++m_) _Pragma("unroll") for (int n_ = 0; n_ < 2; ++n_) asm volatile("" :: "v"(acc[a_][b_][m_][n_])); }
        if (!has_next) break;
#pragma unroll
        for (int a = 0; a < 2; ++a)
#pragma unroll
            for (int b = 0; b < 2; ++b)
#pragma unroll
                for (int m = 0; m < 4; ++m)
#pragma unroll
                    for (int n = 0; n < 2; ++n) acc[a][b][m][n] = (f32x4){0.f, 0.f, 0.f, 0.f};
        cur = nxt; cA = nA; cB = nB; ++ui;
    }
    PG8_WAIT_V(0);
    if (wr == 0) PG8_BAR;
    PG8_BAR;
    if constexpr (Epi::AFTER_DRAIN) E.after(acc, cur, wr, wc, fr, fq, lds);
#undef PG8_SA
#undef PG8_SB
#undef PG8_STAGE
#undef PG8_LDA
#undef PG8_LDB
#undef PG8_MMA
#undef PG8_WAIT_V
#undef PG8_WAIT_L
#undef PG8_BAR
#undef PG8_SCHED
}
}
#define XB_TMO      128
#define XB_XCNT(j)  (256  + 64 * (j))
#define XB_XSUB(j)  (1280 + 64 * (j))
#define XB_XGEN(j)  (2304 + 64 * (j))
#define XB_TOP      3328
#define XB_TOPGEN   3392
#define XCD_BAR_WORDS 3456
#define XB_SPIN_CAP (1u << 18)
#define LAS __attribute__((address_space(3)))

__device__ __forceinline__ unsigned xb_ld(unsigned* p)              { return __hip_atomic_load(p, __ATOMIC_RELAXED, __HIP_MEMORY_SCOPE_AGENT); }
__device__ __forceinline__ unsigned xb_add(unsigned* p, unsigned v) { return __hip_atomic_fetch_add(p, v, __ATOMIC_RELAXED, __HIP_MEMORY_SCOPE_AGENT); }
__device__ __forceinline__ unsigned xb_xcc_id() { return (unsigned)__builtin_amdgcn_s_getreg((3 << 11) | 20) & 0xFu; }
#define XB_SPIN(cond, bar) do { unsigned _sp = 0; while (cond) { __builtin_amdgcn_s_sleep(1); \
    if ((++_sp & 255u) == 0u) { if (xb_ld(&(bar)[XB_TMO])) break; if (_sp > XB_SPIN_CAP) { atomicAdd(&(bar)[XB_TMO], 1u); break; } } } } while (0)

__device__ __forceinline__ unsigned lane_id_now() { unsigned l_; asm volatile("v_mbcnt_lo_u32_b32 %0, -1, 0\n\tv_mbcnt_hi_u32_b32 %0, -1, %0" : "=v"(l_)); return l_; }
__device__ __forceinline__ bool xb_thread0(int wave_idx) { return wave_idx == 0 && lane_id_now() == 0u; }
struct XcdBarrier {
    unsigned* bar; unsigned x; int wave;
    volatile LAS unsigned* st;
};

__device__ __forceinline__ XcdBarrier xcd_barrier_post(unsigned* bar, volatile LAS unsigned* st, int wave_idx) {
    XcdBarrier b; b.bar = bar; b.x = xb_xcc_id(); b.st = st; b.wave = wave_idx;
    if (xb_thread0(wave_idx)) (void)xb_add(&bar[XB_XCNT(b.x)], 1u);
    return b;
}
__device__ __forceinline__ void xcd_barrier_complete(unsigned* bar, unsigned x, unsigned& nloc, unsigned& nx) {
    const unsigned G = gridDim.x * gridDim.y * gridDim.z;
    unsigned sum, cnt, mine, sp = 0u;
    for (;;) {
        sum = 0u; cnt = 0u; mine = 0u;
#pragma unroll
        for (unsigned j = 0; j < 16; ++j) { const unsigned c = xb_ld(&bar[XB_XCNT(j)]); sum += c; cnt += (c > 0u) ? 1u : 0u; mine = (j == x) ? c : mine; }
        if (sum == G) break;
        __builtin_amdgcn_s_sleep(1);
        if ((++sp & 255u) == 0u) { if (xb_ld(&bar[XB_TMO])) break; if (sp > XB_SPIN_CAP) { atomicAdd(&bar[XB_TMO], 1u); break; } }
    }
    nloc = mine > 0u ? mine : 1u; nx = cnt > 0u ? cnt : 1u;
}

__device__ __forceinline__ void xcd_barrier(const XcdBarrier& b) {
    asm volatile("s_waitcnt vmcnt(0)" ::: "memory");
    __syncthreads();
    if (xb_thread0(b.wave)) {
        unsigned* bar = b.bar;
        __builtin_amdgcn_s_waitcnt(0);
        unsigned nloc = b.st[0], nx = b.st[1];
        if (nloc == 0u) { xcd_barrier_complete(bar, b.x, nloc, nx); b.st[0] = nloc; b.st[1] = nx; }
        const unsigned old = xb_add(&bar[XB_XSUB(b.x)], 1u);
        const unsigned gen = old / nloc;
        if (old + 1u == (gen + 1u) * nloc) {
            __builtin_amdgcn_fence(__ATOMIC_RELEASE, "agent");
            asm volatile("s_waitcnt vmcnt(0)" ::: "memory");
            const unsigned og = xb_add(&bar[XB_TOP], 1u);
            const unsigned tg = og / nx;
            if (og + 1u == (tg + 1u) * nx) xb_add(&bar[XB_TOPGEN], 1u);
            else XB_SPIN(xb_ld(&bar[XB_TOPGEN]) == tg, bar);
            __builtin_amdgcn_fence(__ATOMIC_ACQUIRE, "agent");
            xb_add(&bar[XB_XGEN(b.x)], 1u);
            asm volatile("s_waitcnt vmcnt(0)" ::: "memory");
        } else {
            XB_SPIN(xb_ld(&bar[XB_XGEN(b.x)]) == gen, bar);
            __builtin_amdgcn_fence(__ATOMIC_ACQUIRE, "agent");
            asm volatile("s_waitcnt vmcnt(0)" ::: "memory");
        }
    }
    __syncthreads();
}
constexpr int NWAVES = 8, NTHR = 512;
constexpr int B_ = 4, S_ = 4096, D_ = 2048, L_ = 4, M_ = B_ * S_;
constexpr int NIN = 6592, LDP = 6656;
constexpr int C_CQ = 0, C_CKV = 512, C_KR = 768, C_US5 = 832, C_R = 1344, C_K = 1856, C_V = 2368, C_WLO = 2880, C_ALO = 2944,
              C_QD = 3008, C_KD = 3520, C_VD = 4032, C_GATE = 4544;
constexpr int NQ = 768, NKV = 1024;
constexpr float NORM_EPS = 1e-6f, THETA = 500000.f;
constexpr int S5_T = 64, S5_NCH = S_ / S5_T;

enum { I_X = 0, I_POS, I_NORMG, I_WIN, I_WOUT, I_QNG, I_KVNG, I_WUQ, I_WUKV, I_S5ARE, I_S5AIM, I_S5LDT, I_S5BRE, I_S5BIM, I_S5CRE, I_S5CIM, I_S5D, I_S5WGLU, I_S5BGLU,
       I_MU, I_W0, I_W2, I_A0, I_A2, I_KK, I_KA, I_RK, I_LNG, I_LNB, I_LQ1, I_LK1, I_LQ2, I_LK2, I_SUBG, I_FNG, N_INPUTS };

constexpr size_t MiB = 1u << 20;
constexpr size_t WS_CTL = 0, CTL_ZERO_BYTES = 1 * MiB;
constexpr size_t WS_WIN = 1 * MiB;
constexpr size_t WS_WOUT = 105 * MiB;
constexpr size_t WS_WUQ = 137 * MiB;
constexpr size_t WS_WUKV = 140 * MiB;
constexpr size_t WS_WGLU = 142 * MiB;
constexpr size_t WS_H = 144 * MiB;
constexpr size_t WS_MIXED = WS_H;
constexpr size_t WS_PROJ = 208 * MiB;
constexpr size_t WS_CQN = 416 * MiB;
constexpr size_t WS_SSP = 416 * MiB;
constexpr size_t WS_CKVN = 432 * MiB;
constexpr size_t WS_KR = 440 * MiB;
constexpr size_t WS_ROPEA = 442 * MiB;
constexpr size_t WS_ROPED = 446 * MiB;
constexpr size_t WS_QM = 448 * MiB;
constexpr size_t WS_KVM = 472 * MiB;
constexpr size_t WS_WLA = 504 * MiB;
constexpr size_t WS_GACT = 512 * MiB;
constexpr size_t WS_RW = 528 * MiB;
constexpr size_t WS_RWO = 624 * MiB;
constexpr size_t WS_LBT = 656 * MiB;
constexpr size_t WS_RWGT = 658 * MiB;
constexpr size_t WS_RWAW = 660 * MiB;
constexpr size_t WS_RWBT = 724 * MiB;
constexpr size_t WS_RWKT = 756 * MiB;
constexpr size_t WS_END = 788 * MiB;
constexpr size_t WS_ACAT = 788 * MiB;
constexpr size_t WS_S5KZ = 812 * MiB;
constexpr size_t WS_S5W1 = 818 * MiB;
constexpr size_t WS_END2 = 823 * MiB;

constexpr size_t RW_STRIDE = (size_t)M_ * 512;

constexpr int CW_BAR = 4096;
constexpr int CW_Q = 16384;

constexpr int LDS_BYTES = 147456;
constexpr int RSTD_OFF = 136192;
constexpr int MISC_OFF = 131072 + 320;

#define GAS __attribute__((address_space(1)))
typedef unsigned short bf16;
typedef unsigned v4u __attribute__((ext_vector_type(4)));
typedef unsigned v2u __attribute__((ext_vector_type(2)));
typedef float f32x4 __attribute__((ext_vector_type(4)));
typedef float f32x2 __attribute__((ext_vector_type(2)));
typedef float f32x16 __attribute__((ext_vector_type(16)));
typedef short bf16x8 __attribute__((ext_vector_type(8)));
typedef short s16x4 __attribute__((ext_vector_type(4)));

__device__ __forceinline__ unsigned pk2(float lo, float hi) { return pg8::cvt_pk_bf16(lo, hi); }
__device__ __forceinline__ float bflo(unsigned w) { return __uint_as_float(w << 16); }
__device__ __forceinline__ float bfhi(unsigned w) { return __uint_as_float(w & 0xffff0000u); }
__device__ __forceinline__ float bf1(bf16 b) { return __uint_as_float(((unsigned)b) << 16); }
__device__ __forceinline__ bf16 f2bf(float f) { return (bf16)(pk2(f, 0.f) & 0xffffu); }
__device__ __forceinline__ void unpack8(v4u w, float (&f)[8]) { f[0] = bflo(w.x); f[1] = bfhi(w.x); f[2] = bflo(w.y); f[3] = bfhi(w.y); f[4] = bflo(w.z); f[5] = bfhi(w.z); f[6] = bflo(w.w); f[7] = bfhi(w.w); }
__device__ __forceinline__ v4u pack8(const float (&f)[8]) { v4u w; w.x = pk2(f[0], f[1]); w.y = pk2(f[2], f[3]); w.z = pk2(f[4], f[5]); w.w = pk2(f[6], f[7]); return w; }
__device__ __forceinline__ float wave_sum(float v) {
#pragma unroll
    for (int o = 1; o < 64; o <<= 1) v += __shfl_xor(v, o);
    return v;
}
template <int CTRL> __device__ __forceinline__ float dppf(float v) { return __builtin_bit_cast(float, __builtin_amdgcn_update_dpp(0, __builtin_bit_cast(int, v), CTRL, 0xF, 0xF, true)); }
__device__ __forceinline__ float red8(float v) { v += dppf<0xB1>(v); v += dppf<0x4E>(v); v += dppf<0x141>(v); return v; }
__device__ __forceinline__ float red16(float v) { v += dppf<0xB1>(v); v += dppf<0x4E>(v); v += dppf<0x141>(v); v += dppf<0x140>(v); return v; }
__device__ __forceinline__ float readlane_f(float v, int l) { return __builtin_bit_cast(float, __builtin_amdgcn_readlane(__builtin_bit_cast(int, v), l)); }
__device__ __forceinline__ float wave_sum_fast(float v) {
    v = red16(v);
    return (readlane_f(v, 0) + readlane_f(v, 16)) + (readlane_f(v, 32) + readlane_f(v, 48));
}
__device__ __forceinline__ float tanh_fast(float x) { const float e = __expf(2.f * fminf(fmaxf(x, -15.f), 15.f)); return (e - 1.f) / (e + 1.f); }
__device__ __forceinline__ float pair_max(float v) { const auto rr = __builtin_amdgcn_permlane32_swap(__float_as_uint(v), __float_as_uint(v), false, false); return fmaxf(__uint_as_float(rr[0]), __uint_as_float(rr[1])); }
__device__ __forceinline__ float pair_sum(float v) { const auto rr = __builtin_amdgcn_permlane32_swap(__float_as_uint(v), __float_as_uint(v), false, false); return __uint_as_float(rr[0]) + __uint_as_float(rr[1]); }
__device__ __forceinline__ float shfl_up_l(float v, int d, int lane) {
    return __builtin_bit_cast(float, __builtin_amdgcn_ds_bpermute(((lane >= d ? lane - d : lane)) << 2, __builtin_bit_cast(int, v)));
}
__device__ __forceinline__ float exp_raw(float x) { return __builtin_amdgcn_exp2f(x * 1.4426950408889634f); }
__device__ __forceinline__ float log_raw(float x) { return __builtin_amdgcn_logf(x) * 0.6931471805599453f; }
__device__ __forceinline__ float rcp_raw(float x) { return __builtin_amdgcn_rcpf(x); }
__device__ __forceinline__ float sigmoidf_(float x) { return 1.f / (1.f + __expf(-x)); }
__device__ __forceinline__ float siluf_(float x) { return x / (1.f + __expf(-x)); }
__device__ __forceinline__ float gelu_fast(float y) { const float u = 0.7978845608028654f * (y + 0.044715f * y * y * y); return 0.5f * y * (1.f + tanh_fast(u)); }
__device__ __forceinline__ float gelu_tanh(float y) { const float u = 0.7978845608028654f * (y + 0.044715f * y * y * y); return 0.5f * y * (1.f + tanhf(u)); }

struct Args { const void* in[N_INPUTS]; float* out; unsigned char* ws; int ph_lo, ph_hi, rep, pad; };
typedef const __attribute__((address_space(4))) Args* AP;

struct TrItem { const float* W; bf16* WT; const float* gk; int K, N, item; };
__device__ __forceinline__ void tr_load(const TrItem& t, int lane, float (&v)[32], f32x4& ga, f32x4& gb) {
    const int nblk = t.N / 32, kb = t.item / nblk, nb = t.item % nblk, k0 = 64 * kb, n0 = 32 * nb;
    ga = (f32x4){1.f, 1.f, 1.f, 1.f}; gb = ga;
    if (t.gk) { ga = *(const f32x4*)(t.gk + k0 + 8 * (lane & 7)); gb = *(const f32x4*)(t.gk + k0 + 8 * (lane & 7) + 4); }
#pragma unroll
    for (int i = 0; i < 32; ++i) { const int kk = 2 * i + (lane >> 5); v[i] = t.W[(size_t)(k0 + kk) * t.N + n0 + (lane & 31)]; }
}
__device__ __forceinline__ void tr_store(const TrItem& t, float* scr, int lane, const float (&v)[32], const f32x4 ga, const f32x4 gb) {
    const int nblk = t.N / 32, kb = t.item / nblk, nb = t.item % nblk, k0 = 64 * kb, n0 = 32 * nb;
#pragma unroll
    for (int i = 0; i < 32; ++i) { const int kk = 2 * i + (lane >> 5); scr[kk * 33 + (lane & 31)] = v[i]; }
    __builtin_amdgcn_wave_barrier(); asm volatile("s_waitcnt lgkmcnt(0)" ::: "memory");
    const int c = lane & 7;
#pragma unroll
    for (int j = 0; j < 4; ++j) { const int n = (lane >> 3) + 8 * j; const float* s = scr + (8 * c) * 33 + n;
        v4u o; o.x = pk2(s[0 * 33] * ga.x, s[1 * 33] * ga.y); o.y = pk2(s[2 * 33] * ga.z, s[3 * 33] * ga.w); o.z = pk2(s[4 * 33] * gb.x, s[5 * 33] * gb.y); o.w = pk2(s[6 * 33] * gb.z, s[7 * 33] * gb.w);
        *(v4u*)(t.WT + (size_t)(n0 + n) * t.K + k0 + 8 * c) = o; }
    __builtin_amdgcn_wave_barrier(); asm volatile("s_waitcnt lgkmcnt(0)" ::: "memory");
}
__device__ __forceinline__ TrItem tr_decode(AP a, int it) {
    constexpr int I_IN = (D_ / 64) * (NIN / 32), I_OUT = (D_ / 64) * (D_ / 32), I_UQ = (512 / 64) * (NQ / 32), I_UKV = (256 / 64) * (NKV / 32), I_GLU = (512 / 64) * (512 / 32);
    constexpr int PER_L = I_IN + I_OUT + I_UQ + I_UKV + I_GLU;
    const int l = it / PER_L; int r = it % PER_L;
    if (r < I_IN) return TrItem{(const float*)a->in[I_WIN] + (size_t)l * D_ * NIN, (bf16*)(a->ws + WS_WIN) + (size_t)l * LDP * D_, (const float*)a->in[I_NORMG] + l * D_, D_, NIN, r}; r -= I_IN;
    if (r < I_OUT) return TrItem{(const float*)a->in[I_WOUT] + (size_t)l * D_ * D_, (bf16*)(a->ws + WS_WOUT) + (size_t)l * D_ * D_, nullptr, D_, D_, r}; r -= I_OUT;
    if (r < I_UQ) return TrItem{(const float*)a->in[I_WUQ] + (size_t)l * 512 * NQ, (bf16*)(a->ws + WS_WUQ) + (size_t)l * NQ * 512, nullptr, 512, NQ, r}; r -= I_UQ;
    if (r < I_UKV) return TrItem{(const float*)a->in[I_WUKV] + (size_t)l * 256 * NKV, (bf16*)(a->ws + WS_WUKV) + (size_t)l * NKV * 256, nullptr, 256, NKV, r}; r -= I_UKV;
    return TrItem{(const float*)a->in[I_S5WGLU] + (size_t)l * 512 * 512, (bf16*)(a->ws + WS_WGLU) + (size_t)l * 512 * 512, nullptr, 512, 512, r};
}
__device__ __forceinline__ void phase_convert(AP a, unsigned char* lds, int gw, int NGW, int wave, int lane) {
    float* scr = (float*)(lds + wave * 16384);
    constexpr int I_IN = (D_ / 64) * (NIN / 32), I_OUT = (D_ / 64) * (D_ / 32), I_UQ = (512 / 64) * (NQ / 32), I_UKV = (256 / 64) * (NKV / 32), I_GLU = (512 / 64) * (512 / 32);
    constexpr int TOTAL = L_ * (I_IN + I_OUT + I_UQ + I_UKV + I_GLU);
    {   TrItem cur{}; float v[32]; f32x4 ga = {1.f, 1.f, 1.f, 1.f}, gb = ga;
        if (gw < TOTAL) { cur = tr_decode(a, gw); tr_load(cur, lane, v, ga, gb); }
        for (int it = gw; it < TOTAL; it += NGW) {
            TrItem nx{}; float nv[32]; f32x4 nga = ga, ngb = gb; const bool more = it + NGW < TOTAL;
            if (more) { nx = tr_decode(a, it + NGW); tr_load(nx, lane, nv, nga, ngb); }
            tr_store(cur, scr, lane, v, ga, gb);
            if (more) { cur = nx; ga = nga; gb = ngb;
#pragma unroll
                for (int i = 0; i < 32; ++i) v[i] = nv[i]; }
        }
    }
    for (int i = gw * 64 + lane; i < L_ * 16384; i += NGW * 64) { const int l = i / 16384, o = i % 16384;
        unsigned z = 0u; asm volatile("" : "+v"(z));
        *(v4u*)((bf16*)(a->ws + WS_WIN) + ((size_t)l * LDP + NIN) * D_ + (size_t)o * 8) = (v4u){z, z, z, z}; }
    for (int i = gw * 64 + lane; i < L_ * 1024 * 32; i += NGW * 64) { const int l = i >> 15, n = (i >> 5) & 1023, k0 = (i & 31) * 8; float x[8];
        const float* src = (n < 512) ? (const float*)a->in[I_W2] + (size_t)l * 64 * 512 + n : (const float*)a->in[I_A2] + (size_t)l * 64 * 512 + (n - 512);
        const int kb = (n < 512) ? k0 : k0 - 64;
#pragma unroll
        for (int j = 0; j < 8; ++j) x[j] = (kb >= 0 && kb < 64) ? src[(size_t)(kb + j) * 512] : 0.f;
        *(v4u*)((bf16*)(a->ws + WS_LBT) + ((size_t)l * 1024 + n) * 256 + k0) = pack8(x); }
    {   const float* src = (const float*)a->in[I_X]; bf16* xb = (bf16*)a->out; float* ss = (float*)(a->ws + WS_SSP);
        f32x4 nv[8];
        if (gw < M_) { const f32x4* xr = (const f32x4*)(src + (size_t)gw * D_) + lane;
#pragma unroll
            for (int j = 0; j < 8; ++j) nv[j] = xr[64 * j]; }
        for (int m = gw; m < M_; m += NGW) {
            v2u* o = (v2u*)(xb + (size_t)m * D_) + lane;
            f32x4 v[8]; float sq = 0.f;
#pragma unroll
            for (int j = 0; j < 8; ++j) { v[j] = nv[j]; sq += (v[j].x * v[j].x + v[j].y * v[j].y) + (v[j].z * v[j].z + v[j].w * v[j].w); }
            if (m + NGW < M_) { const f32x4* xr = (const f32x4*)(src + (size_t)(m + NGW) * D_) + lane;
#pragma unroll
                for (int j = 0; j < 8; ++j) nv[j] = xr[64 * j]; }
#pragma unroll
            for (int j = 0; j < 8; ++j) { v2u w; w.x = pk2(v[j].x, v[j].y); w.y = pk2(v[j].z, v[j].w); o[64 * j] = w; }
            sq = wave_sum_fast(sq);
            if (lane < 32) ss[(size_t)m * 32 + lane] = (lane == 0) ? sq : 0.f;
        }
    }
    const int* pos = (const int*)a->in[I_POS];
    float* cA = (float*)(a->ws + WS_ROPEA); float* sA = cA + (size_t)M_ * 32; float* cD = (float*)(a->ws + WS_ROPED); float* sD = cD + (size_t)M_ * 8;
    for (int m = gw; m < M_; m += NGW) {
        const float p = (float)pos[m];
        if (lane < 32) { const float inv = powf(THETA, -(float)(2 * lane) / 64.f); float sn, cs; sincosf(p * inv, &sn, &cs); cA[(size_t)m * 32 + lane] = cs; sA[(size_t)m * 32 + lane] = sn; }
        else if (lane < 40) { const int j = lane - 32; const float inv = powf(THETA, -(float)(2 * j) / 16.f); float sn, cs; sincosf(p * inv, &sn, &cs); cD[(size_t)m * 8 + j] = cs; sD[(size_t)m * 8 + j] = sn; }
    }
}

template <bool OUT_F32>
__device__ __forceinline__ void phase_rmsnorm(const float* src, const float* g, void* dst, int gw, int NGW, int lane) {
    f32x4 gv[8];
#pragma unroll
    for (int j = 0; j < 8; ++j) gv[j] = ((const f32x4*)g)[64 * j + lane];
    f32x4 nv[8];
    if (gw < M_) { const f32x4* xr = (const f32x4*)(src + (size_t)gw * D_) + lane;
#pragma unroll
        for (int j = 0; j < 8; ++j) nv[j] = xr[64 * j]; }
    for (int m = gw; m < M_; m += NGW) {
        f32x4 v[8]; float s = 0.f;
#pragma unroll
        for (int j = 0; j < 8; ++j) { v[j] = nv[j]; s += (v[j].x * v[j].x + v[j].y * v[j].y) + (v[j].z * v[j].z + v[j].w * v[j].w); }
        if (m + NGW < M_) { const f32x4* xr = (const f32x4*)(src + (size_t)(m + NGW) * D_) + lane;
#pragma unroll
            for (int j = 0; j < 8; ++j) nv[j] = xr[64 * j]; }
        const float rstd = 1.f / sqrtf(wave_sum_fast(s) * (1.f / D_) + NORM_EPS);
        if (OUT_F32) { f32x4* o = (f32x4*)((float*)dst + (size_t)m * D_) + lane;
#pragma unroll
            for (int j = 0; j < 8; ++j) o[64 * j] = v[j] * rstd * gv[j];
        } else { v2u* o = (v2u*)((bf16*)dst + (size_t)m * D_) + lane;
#pragma unroll
            for (int j = 0; j < 8; ++j) { const f32x4 y = v[j] * rstd * gv[j]; v2u w; w.x = pk2(y.x, y.y); w.y = pk2(y.z, y.w); o[64 * j] = w; } }
    }
}

struct EpiBf16 {
    static constexpr bool PERM = true, AFTER_DRAIN = false;
    bf16* O; int ldc;
    __device__ __forceinline__ void operator()(const f32x4 (&acc)[2][2][4][2], const pg8::Unit& u, int wr, int wc, int fr, int fq) const {
        const int row0 = u.pm * 256 + wr * 64 + fr, col0 = u.pn * 256 + wc * 32 + 8 * fq;
#pragma unroll
        for (int ai = 0; ai < 2; ++ai)
#pragma unroll
            for (int m = 0; m < 4; ++m) { bf16* rowp = O + (size_t)(row0 + ai * 128 + m * 16) * ldc + col0;
#pragma unroll
                for (int bj = 0; bj < 2; ++bj) { const f32x4 v0 = acc[ai][bj][m][0], v1 = acc[ai][bj][m][1];
                    v4u o; o.x = pk2(v0[0], v0[1]); o.y = pk2(v0[2], v0[3]); o.z = pk2(v1[0], v1[1]); o.w = pk2(v1[2], v1[3]);
                    *(v4u*)(rowp + bj * 128) = o; } }
    }
};
struct EpiBf16Rs {
    static constexpr bool PERM = true, AFTER_DRAIN = false;
    bf16* O; int ldc; const float* ss; const LAS float* RS; int pm_tab;
    __device__ __forceinline__ void operator()(const f32x4 (&acc)[2][2][4][2], const pg8::Unit& u, int wr, int wc, int fr, int fq) const {
        const int rl0 = wr * 64 + fr, col0 = u.pn * 256 + wc * 32 + 8 * fq;
#pragma unroll
        for (int ai = 0; ai < 2; ++ai)
#pragma unroll
            for (int m = 0; m < 4; ++m) { const int rl = rl0 + ai * 128 + m * 16, row = u.pm * 256 + rl; bf16* rowp = O + (size_t)row * ldc + col0;
                float rs;
                if (u.pm == pm_tab) rs = RS[rl];
                else { float tot = 0.f;
#pragma unroll
                    for (int q = 0; q < 8; ++q) { const f32x4 p4 = *(const f32x4*)(ss + (size_t)row * 32 + 4 * q); tot += (p4.x + p4.y) + (p4.z + p4.w); }
                    rs = 1.f / sqrtf(tot * (1.f / D_) + NORM_EPS); }
#pragma unroll
                for (int bj = 0; bj < 2; ++bj) { const f32x4 v0 = acc[ai][bj][m][0] * rs, v1 = acc[ai][bj][m][1] * rs;
                    v4u o; o.x = pk2(v0[0], v0[1]); o.y = pk2(v0[2], v0[3]); o.z = pk2(v1[0], v1[1]); o.w = pk2(v1[2], v1[3]);
                    *(v4u*)(rowp + bj * 128) = o; } }
    }
};
struct EpiLora {
    static constexpr bool PERM = true, AFTER_DRAIN = true;
    AP a; int l; bool dry;
    __device__ __forceinline__ void after(const f32x4 (&acc)[2][2][4][2], const pg8::Unit& u, int wr, int wc, int fr, int fq, LAS unsigned char*) const {
        const float* w0 = (const float*)a->in[I_W0] + l * 512; const float* a0 = (const float*)a->in[I_A0] + l * 512; const float* k_a = (const float*)a->in[I_KA] + l * 512; bf16* rw = (bf16*)(a->ws + WS_RW);
        const int ln_ = (int)lane_id_now();
        const int fr_ = ln_ & 15, fq_ = ln_ >> 4;
        const int row0 = u.pm * 256 + wr * 64 + fr_, col0 = u.pn * 256 + wc * 32 + 8 * fq_;
        if (u.pn < 2) {
#pragma unroll
            for (int bj = 0; bj < 2; ++bj) { const int col = col0 + bj * 128;
                float wv[8]; *(f32x4*)&wv[0] = *(const f32x4*)(w0 + col); *(f32x4*)&wv[4] = *(const f32x4*)(w0 + col + 4);
#pragma unroll
                for (int ai = 0; ai < 2; ++ai)
#pragma unroll
                    for (int m = 0; m < 4; ++m) { const size_t o = (size_t)(row0 + ai * 128 + m * 16) * 512 + col; float ev[8];
#pragma unroll
                        for (int e = 0; e < 8; ++e) { const float nx = -(wv[e] + acc[ai][bj][m][e >> 2][e & 3]); const float sp = fmaxf(nx, 0.f) + log_raw(1.f + exp_raw(-fabsf(nx))); ev[e] = exp_raw(-sp - 0.5f); }
                        *(v4u*)(rw + 5 * RW_STRIDE + o) = pack8(ev); __builtin_amdgcn_sched_barrier(0); } }
        } else {
#pragma unroll
            for (int bj = 0; bj < 2; ++bj) { const int c = col0 + bj * 128 - 512; float av[8], kav[8];
                *(f32x4*)&av[0] = *(const f32x4*)(a0 + c); *(f32x4*)&av[4] = *(const f32x4*)(a0 + c + 4); *(f32x4*)&kav[0] = *(const f32x4*)(k_a + c); *(f32x4*)&kav[4] = *(const f32x4*)(k_a + c + 4);
                v4u kr_[2][4];
#pragma unroll
                for (int ai = 0; ai < 2; ++ai)
#pragma unroll
                    for (int m = 0; m < 4; ++m) kr_[ai][m] = *(const v4u*)(rw + 1 * RW_STRIDE + (size_t)(row0 + ai * 128 + m * 16) * 512 + c);
#pragma unroll
                for (int ai = 0; ai < 2; ++ai)
#pragma unroll
                    for (int m = 0; m < 4; ++m) { const size_t o = (size_t)(row0 + ai * 128 + m * 16) * 512 + c; float al[8], k8[8], kp[8];
                        unpack8(kr_[ai][m], k8);
#pragma unroll
                        for (int e = 0; e < 8; ++e) { al[e] = rcp_raw(1.f + exp_raw(-(av[e] + acc[ai][bj][m][e >> 2][e & 3]))); kp[e] = k8[e] * (1.f + (al[e] - 1.f) * kav[e]); }
                        *(v4u*)(rw + 4 * RW_STRIDE + o) = pack8(al);
                        if (!dry) *(v4u*)(rw + 1 * RW_STRIDE + o) = pack8(kp); __builtin_amdgcn_sched_barrier(0); } }
        }
    }
};
struct EpiGlu {
    static constexpr bool PERM = true, AFTER_DRAIN = false;
    const bf16* G; const float* bias; const bf16* proj; bf16* mixed;
    __device__ __forceinline__ void operator()(const f32x4 (&acc)[2][2][4][2], const pg8::Unit& u, int wr, int wc, int fr, int fq) const {
        const int row0 = u.pm * 256 + wr * 64 + fr, col0 = u.pn * 256 + wc * 32 + 8 * fq;
        float bv[2][8];
#pragma unroll
        for (int bj = 0; bj < 2; ++bj) { *(f32x4*)&bv[bj][0] = *(const f32x4*)(bias + col0 + bj * 128); *(f32x4*)&bv[bj][4] = *(const f32x4*)(bias + col0 + bj * 128 + 4); }
#pragma unroll
        for (int ai = 0; ai < 2; ++ai) {
            v4u gr[4][2], tr[4][2];
#pragma unroll
            for (int m = 0; m < 4; ++m)
#pragma unroll
                for (int bj = 0; bj < 2; ++bj) { const int row = row0 + ai * 128 + m * 16, col = col0 + bj * 128;
                    gr[m][bj] = *(const v4u*)(G + (size_t)row * 512 + col); tr[m][bj] = *(const v4u*)(proj + (size_t)row * LDP + C_GATE + 512 + col); }
#pragma unroll
            for (int m = 0; m < 4; ++m) { const int row = row0 + ai * 128 + m * 16;
#pragma unroll
                for (int bj = 0; bj < 2; ++bj) { const int col = col0 + bj * 128;
                    float gv[8], gt[8], r[8]; unpack8(gr[m][bj], gv); unpack8(tr[m][bj], gt);
#pragma unroll
                    for (int e = 0; e < 8; ++e) { const float x = acc[ai][bj][m][e >> 2][e & 3] + bv[bj][e]; r[e] = gv[e] * sigmoidf_(x) * siluf_(gt[e]); }
                    *(v4u*)(mixed + (size_t)row * D_ + 512 + col) = pack8(r); } }
        }
    }
};
struct EpiResid {
    static constexpr bool PERM = false, AFTER_DRAIN = false;
    const float* xin; float* out;
    __device__ __forceinline__ void operator()(const f32x4 (&acc)[2][2][4][2], const pg8::Unit& u, int wr, int wc, int fr, int fq) const {
        const int row0 = u.pm * 256 + wr * 64 + fr, col0 = u.pn * 256 + wc * 32 + 4 * fq;
#pragma unroll
        for (int ai = 0; ai < 2; ++ai)
#pragma unroll
            for (int m = 0; m < 4; ++m) { const size_t ro = (size_t)(row0 + ai * 128 + m * 16) * D_ + col0;
#pragma unroll
                for (int bj = 0; bj < 2; ++bj)
#pragma unroll
                    for (int n = 0; n < 2; ++n) *(f32x4*)(out + ro + bj * 128 + n * 16) = *(const f32x4*)(xin + ro + bj * 128 + n * 16) + acc[ai][bj][m][n]; }
    }
};
struct EpiResidX {
    static constexpr bool PERM = true, AFTER_DRAIN = false;
    const float* xin_f; const bf16* xin_b; bf16* xout_b; float* xout_f; float* ssn;
    __device__ __forceinline__ void operator()(const f32x4 (&acc)[2][2][4][2], const pg8::Unit& u, int wr, int wc, int fr, int fq) const {
        const int row0 = u.pm * 256 + wr * 64 + fr, col0 = u.pn * 256 + wc * 32 + 8 * fq;
#pragma unroll
        for (int ai = 0; ai < 2; ++ai) {
            float x[4][2][8];
            if (xin_f) {
#pragma unroll
                for (int m = 0; m < 4; ++m)
#pragma unroll
                    for (int bj = 0; bj < 2; ++bj) { const float* p = xin_f + (size_t)(row0 + ai * 128 + m * 16) * D_ + col0 + bj * 128; *(f32x4*)&x[m][bj][0] = *(const f32x4*)p; *(f32x4*)&x[m][bj][4] = *(const f32x4*)(p + 4); }
            } else { v4u raw[4][2];
#pragma unroll
                for (int m = 0; m < 4; ++m)
#pragma unroll
                    for (int bj = 0; bj < 2; ++bj) raw[m][bj] = *(const v4u*)(xin_b + (size_t)(row0 + ai * 128 + m * 16) * D_ + col0 + bj * 128);
#pragma unroll
                for (int m = 0; m < 4; ++m)
#pragma unroll
                    for (int bj = 0; bj < 2; ++bj) unpack8(raw[m][bj], x[m][bj]);
            }
#pragma unroll
            for (int m = 0; m < 4; ++m) { const int row = row0 + ai * 128 + m * 16; const size_t ro = (size_t)row * D_ + col0; float sq = 0.f;
#pragma unroll
                for (int bj = 0; bj < 2; ++bj) { float y[8];
#pragma unroll
                    for (int e = 0; e < 8; ++e) { y[e] = x[m][bj][e] + acc[ai][bj][m][e >> 2][e & 3]; sq += y[e] * y[e]; }
                    if (xout_f) { *(f32x4*)(xout_f + ro + bj * 128) = (f32x4){y[0], y[1], y[2], y[3]}; *(f32x4*)(xout_f + ro + bj * 128 + 4) = (f32x4){y[4], y[5], y[6], y[7]}; }
                    else *(v4u*)(xout_b + ro + bj * 128) = pack8(y); }
                if (!xout_f) { sq += __shfl_xor(sq, 16); sq += __shfl_xor(sq, 32);
                    if (fq == 0) ssn[(size_t)row * 32 + u.pn * 4 + wc] = sq; } }
        }
    }
};
constexpr int PT = 4;
struct PrepRaw { v4u cq, us5, zc[3], zp[3]; v2u ckv; unsigned short kr1, kr2, qd1, qd2, kd1, kd2, wc, wp, ac, ap; float cA, sA, cD, sD; };
__device__ __forceinline__ void phase_prep(AP a, int l, int gw, int NGW, int lane, bool do_rope) {
    bf16* proj = (bf16*)(a->ws + WS_PROJ);
    bf16* cqn = (bf16*)(a->ws + WS_CQN); bf16* ckvn = (bf16*)(a->ws + WS_CKVN); bf16* kr = (bf16*)(a->ws + WS_KR);
    const float* cA = (const float*)(a->ws + WS_ROPEA); const float* sA = cA + (size_t)M_ * 32; const float* cD = (const float*)(a->ws + WS_ROPED); const float* sD = cD + (size_t)M_ * 8;
    bf16* rw = (bf16*)(a->ws + WS_RW);
    const float* gq = (const float*)a->in[I_QNG] + l * 512; const float* gkv = (const float*)a->in[I_KVNG] + l * 256;
    const float* mu = (const float*)a->in[I_MU] + l * 1664;
    const float* k_k = (const float*)a->in[I_KK] + l * 512;
    bf16* wla = (bf16*)(a->ws + WS_WLA);
    const int l31 = lane & 31, ch = lane >> 3, j = lane & 7;
    for (int pr = gw; pr < M_ / PT; pr += NGW) {
        PrepRaw R[PT];
#pragma unroll
        for (int tt = 0; tt < PT; ++tt) {
            const int m = PT * pr + tt; const bool has_prev = (m % S_) != 0;
            const bf16* prow = proj + (size_t)m * LDP; const bf16* pprev = has_prev ? prow - LDP : prow;
            R[tt].cq = *(const v4u*)(prow + C_CQ + lane * 8); R[tt].ckv = *(const v2u*)(prow + C_CKV + lane * 4);
            R[tt].kr1 = prow[C_KR + l31]; R[tt].kr2 = prow[C_KR + 32 + l31]; R[tt].cA = cA[(size_t)m * 32 + l31]; R[tt].sA = sA[(size_t)m * 32 + l31];
            R[tt].qd1 = prow[C_QD + ch * 64 + j]; R[tt].qd2 = prow[C_QD + ch * 64 + j + 8]; R[tt].kd1 = prow[C_KD + ch * 64 + j]; R[tt].kd2 = prow[C_KD + ch * 64 + j + 8];
            R[tt].cD = cD[(size_t)m * 8 + j]; R[tt].sD = sD[(size_t)m * 8 + j];
            R[tt].us5 = *(const v4u*)(prow + C_US5 + lane * 8);
#pragma unroll
            for (int sec = 0; sec < 3; ++sec) { R[tt].zc[sec] = *(const v4u*)(prow + C_R + sec * 512 + lane * 8); R[tt].zp[sec] = *(const v4u*)(pprev + C_R + sec * 512 + lane * 8); }
            R[tt].wc = prow[C_WLO + lane]; R[tt].wp = pprev[C_WLO + lane]; R[tt].ac = prow[C_ALO + lane]; R[tt].ap = pprev[C_ALO + lane];
        }
#pragma unroll
        for (int tt = 0; tt < PT; ++tt) {
            const int m = PT * pr + tt; const bool has_prev = (m % S_) != 0;
            bf16* prow = proj + (size_t)m * LDP;
            { float x[8]; unpack8(R[tt].cq, x); float ss = 0.f;
#pragma unroll
              for (int e = 0; e < 8; ++e) ss += x[e] * x[e];
              const float rstd = 1.f / sqrtf(wave_sum_fast(ss) * (1.f / 512.f) + NORM_EPS);
              const f32x4 g0 = *(const f32x4*)(gq + lane * 8), g1 = *(const f32x4*)(gq + lane * 8 + 4);
#pragma unroll
              for (int e = 0; e < 8; ++e) x[e] = x[e] * rstd * (e < 4 ? g0[e & 3] : g1[e & 3]);
              *(v4u*)(cqn + (size_t)m * 512 + lane * 8) = pack8(x); }
            { const v2u w = R[tt].ckv; float x0 = bflo(w.x), x1 = bfhi(w.x), x2 = bflo(w.y), x3 = bfhi(w.y);
              const float rstd = 1.f / sqrtf(wave_sum_fast(x0 * x0 + x1 * x1 + x2 * x2 + x3 * x3) * (1.f / 256.f) + NORM_EPS);
              const f32x4 g = *(const f32x4*)(gkv + lane * 4);
              v2u o; o.x = pk2(x0 * rstd * g.x, x1 * rstd * g.y); o.y = pk2(x2 * rstd * g.z, x3 * rstd * g.w);
              *(v2u*)(ckvn + (size_t)m * 256 + lane * 4) = o; }
            { const float x1 = bf1(R[tt].kr1), x2 = bf1(R[tt].kr2), c = R[tt].cA, sn = R[tt].sA;
              if (lane < 32) { kr[(size_t)m * 64 + lane] = f2bf(x1 * c - x2 * sn); kr[(size_t)m * 64 + 32 + lane] = f2bf(x2 * c + x1 * sn); } }
            { const float c = R[tt].cD, sn = R[tt].sD; const float q1 = bf1(R[tt].qd1), q2 = bf1(R[tt].qd2), k1 = bf1(R[tt].kd1), k2 = bf1(R[tt].kd2);
              if (do_rope) { bf16* pq = prow + C_QD + ch * 64; bf16* pk = prow + C_KD + ch * 64;
                  pq[j] = f2bf(q1 * c - q2 * sn); pq[j + 8] = f2bf(q2 * c + q1 * sn); pk[j] = f2bf(k1 * c - k2 * sn); pk[j + 8] = f2bf(k2 * c + k1 * sn); } }
            { const int tt_ = m % S_, bb_ = m / S_;
              *(v4u*)((bf16*)(a->ws + WS_ACAT) + ((size_t)((lane >> 1) * 1024 + bb_ * 256 + (tt_ >> 4))) * 384 + (tt_ & 15) * 16 + (lane & 1) * 8) = R[tt].us5; }
            { float zc[8], zp[8], z[8];
#pragma unroll
              for (int sec = 0; sec < 3; ++sec) {
                  unpack8(R[tt].zc[sec], zc); unpack8(R[tt].zp[sec], zp);
                  const f32x4 m0 = *(const f32x4*)(mu + sec * 512 + lane * 8), m1 = *(const f32x4*)(mu + sec * 512 + lane * 8 + 4);
#pragma unroll
                  for (int e = 0; e < 8; ++e) { const float zpe = has_prev ? zp[e] : 0.f; z[e] = zc[e] + (zpe - zc[e]) * (e < 4 ? m0[e & 3] : m1[e & 3]); }
                  *(v4u*)(rw + sec * RW_STRIDE + (size_t)m * 512 + lane * 8) = pack8(z);
                  if (sec == 1) { float kkv[8]; float ss = 0.f;
                      const f32x4 kc0 = *(const f32x4*)(k_k + lane * 8), kc1 = *(const f32x4*)(k_k + lane * 8 + 4);
#pragma unroll
                      for (int e = 0; e < 8; ++e) { kkv[e] = z[e] * (e < 4 ? kc0[e & 3] : kc1[e & 3]); ss += kkv[e] * kkv[e]; }
                      ss = red8(ss); const float inv = 1.f / fmaxf(sqrtf(ss), 1e-12f);
#pragma unroll
                      for (int e = 0; e < 8; ++e) kkv[e] *= inv;
                      *(v4u*)(rw + 3 * RW_STRIDE + (size_t)m * 512 + lane * 8) = pack8(kkv); } }
              const float wc_ = bf1(R[tt].wc), wp_ = has_prev ? bf1(R[tt].wp) : 0.f;
              wla[(size_t)m * 256 + lane] = f2bf(tanh_fast(wc_ + (wp_ - wc_) * mu[1536 + lane]));
              const float ac_ = bf1(R[tt].ac), ap_ = has_prev ? bf1(R[tt].ap) : 0.f;
              wla[(size_t)m * 256 + 64 + lane] = f2bf(ac_ + (ap_ - ac_) * mu[1600 + lane]);
              unsigned z0 = 0u; asm volatile("" : "+v"(z0)); *(unsigned*)(wla + (size_t)m * 256 + 128 + 2 * lane) = z0; }
        }
    }
}

struct S5Par { float abr, abi; f32x2 bb[16]; };
__device__ __forceinline__ void s5_ab(AP a, int l, int g, int p, float& abr, float& abi, float& lr, float& li) {
    lr = fminf(((const float*)a->in[I_S5ARE])[(l * 32 + g) * 64 + p], -1e-4f); li = ((const float*)a->in[I_S5AIM])[(l * 32 + g) * 64 + p];
    const float dt = expf(((const float*)a->in[I_S5LDT])[l * 32 + g]);
    const float mag = expf(dt * lr); float sn, cs; sincosf(dt * li, &sn, &cs); abr = mag * cs; abi = mag * sn;
}
__device__ __forceinline__ void s5_params(AP a, int l, int g, int p, S5Par& P) {
    float lr, li; s5_ab(a, l, g, p, P.abr, P.abi, lr, li);
    const float den = lr * lr + li * li, nr = P.abr - 1.f, ni = P.abi;
    const float fre = (nr * lr + ni * li) / den, fim = (ni * lr - nr * li) / den;
    const float* br = (const float*)a->in[I_S5BRE] + ((size_t)(l * 32 + g) * 64 + p) * 16; const float* bi = (const float*)a->in[I_S5BIM] + ((size_t)(l * 32 + g) * 64 + p) * 16;
#pragma unroll
    for (int c4 = 0; c4 < 4; ++c4) { const f32x4 r = *(const f32x4*)(br + 4 * c4), i = *(const f32x4*)(bi + 4 * c4);
#pragma unroll
        for (int e = 0; e < 4; ++e) P.bb[4 * c4 + e] = (f32x2){fre * r[e] - fim * i[e], fre * i[e] + fim * r[e]}; }
}
constexpr int AT_VSTR = 256;
template <int TYPE> struct AtCfg;
template <> struct AtCfg<0> { static constexpr int DKT = 192, NKS = 12, QR = 256, KSTR = 384, KCH = 24, KPT = 3; };
template <> struct AtCfg<1> { static constexpr int DKT = 128, NKS = 4, QR = 128, KSTR = 256, KCH = 16, KPT = 2; };
__device__ __forceinline__ int crow(int r, int hi) { return (r & 3) + 8 * (r >> 2) + 4 * hi; }

template <int TYPE, int PROBE = 0>
__device__ __forceinline__ void attn_unit(AP a, int l, unsigned char* lds, int b, int hd, int qb, float lam, float lam_init, const int tid) {
    typedef AtCfg<TYPE> C;
    constexpr int STAGE = 64 * C::KSTR + 64 * AT_VSTR;
    const int wid = __builtin_amdgcn_readfirstlane(tid >> 6), lane_ = tid & 63, r32 = lane_ & 31, hi_ = lane_ >> 5;
    const int q0 = qb * C::QR;
    const int qw = q0 + (TYPE == 0 ? wid : (wid & 3)) * 32;
    const int map = TYPE == 0 ? 0 : (wid >> 2);
    const int nkt = (q0 + C::QR) / 64, wnkt = (qw + 31) / 64 + 1;
    const bf16* proj = (const bf16*)(a->ws + WS_PROJ);
    const bf16* kvm = (const bf16*)(a->ws + WS_KVM); const bf16* krp = (const bf16*)(a->ws + WS_KR);
    const size_t tq_ = (size_t)b * S_ + qw + r32;
    bf16x8 q[C::NKS];
    if (TYPE == 0) {
        const bf16* qp = (const bf16*)(a->ws + WS_QM) + tq_ * NQ + hd * 192 + 8 * hi_;
#pragma unroll
        for (int ks = 0; ks < 12; ++ks) q[ks] = *(const bf16x8*)(qp + ks * 16);
        const float* cA = (const float*)(a->ws + WS_ROPEA) + tq_ * 32; const float* sA = (const float*)(a->ws + WS_ROPEA) + (size_t)M_ * 32 + tq_ * 32;
#pragma unroll
        for (int kp = 0; kp < 2; ++kp) {
            float x1[8], x2[8], cs[8], sn[8];
            unpack8(*reinterpret_cast<v4u*>(&q[8 + kp]), x1); unpack8(*reinterpret_cast<v4u*>(&q[10 + kp]), x2);
            *(f32x4*)&cs[0] = *(const f32x4*)(cA + kp * 16 + 8 * hi_); *(f32x4*)&cs[4] = *(const f32x4*)(cA + kp * 16 + 8 * hi_ + 4);
            *(f32x4*)&sn[0] = *(const f32x4*)(sA + kp * 16 + 8 * hi_); *(f32x4*)&sn[4] = *(const f32x4*)(sA + kp * 16 + 8 * hi_ + 4);
            float y1[8], y2[8];
#pragma unroll
            for (int e = 0; e < 8; ++e) { y1[e] = x1[e] * cs[e] - x2[e] * sn[e]; y2[e] = x2[e] * cs[e] + x1[e] * sn[e]; }
            v4u w1 = pack8(y1), w2 = pack8(y2); q[8 + kp] = *reinterpret_cast<bf16x8*>(&w1); q[10 + kp] = *reinterpret_cast<bf16x8*>(&w2);
        }
    } else {
        const bf16* qp = proj + tq_ * LDP + C_QD + hd * 128 + map * 64 + 8 * hi_;
#pragma unroll
        for (int ks = 0; ks < 4; ++ks) q[ks] = *(const bf16x8*)(qp + ks * 16);
    }
    const float Cs = (TYPE == 0 ? 0.07216878364870322f : 0.125f) * 1.4426950408889634f;
    f32x16 o[4];
#pragma unroll
    for (int d = 0; d < 4; ++d)
#pragma unroll
        for (int i = 0; i < 16; ++i) o[d][i] = 0.f;
    float mrun = -INFINITY, lsum = 0.f;
    LAS unsigned char* ldsl = (LAS unsigned char*)lds;
    auto dma = [&](int kt, int buf) {
        const size_t tk0 = (size_t)b * S_ + (size_t)kt * 64;
#pragma unroll
        for (int i = 0; i < C::KPT; ++i) { const int sg = (i * 8 + wid) * 64 + lane_, r = sg / C::KCH, cp = sg % C::KCH;
            const int cc = (TYPE == 0) ? ((cp & ~7) | ((cp & 7) ^ ((r >> 1) & 7))) : (cp ^ (r & 15));
            const bf16* src;
            if (TYPE == 0) src = (cc < 16) ? kvm + (tk0 + r) * NKV + hd * 256 + cc * 8 : krp + (tk0 + r) * 64 + (cc - 16) * 8;
            else src = proj + (tk0 + r) * LDP + C_KD + hd * 128 + cc * 8;
            __builtin_amdgcn_global_load_lds((const unsigned*)src, (LAS unsigned*)(ldsl + buf * STAGE + (i * 8 + wid) * 1024), 16, 0, 0); }
#pragma unroll
        for (int i = 0; i < 2; ++i) { const int sg = (i * 8 + wid) * 64 + lane_, r = sg >> 4, cp = sg & 15, cc = cp ^ ((r & 3) << 2);
            const bf16* src = (TYPE == 0) ? kvm + (tk0 + r) * NKV + hd * 256 + 128 + cc * 8 : proj + (tk0 + r) * LDP + C_VD + hd * 128 + cc * 8;
            __builtin_amdgcn_global_load_lds((const unsigned*)src, (LAS unsigned*)(ldsl + buf * STAGE + 64 * C::KSTR + (i * 8 + wid) * 1024), 16, 0, 0); }
    };
    int koff[4], voff[4];
    {   const int g16 = lane_ >> 4, i16 = lane_ & 15, qq = i16 >> 2, pp = i16 & 3;
#pragma unroll
        for (int x = 0; x < 4; ++x) {
            if (TYPE == 0) { const int f = (r32 >> 1) & 7; koff[x] = r32 * C::KSTR + 16 * ((2 * (x ^ (f >> 1))) + (hi_ ^ (f & 1))); }
            else { const int f = r32 & 15; koff[x] = r32 * C::KSTR + 16 * (8 * (map ^ (f >> 3)) + 2 * (x ^ ((f >> 1) & 3)) + (hi_ ^ (f & 1))); }
            voff[x] = (4 * hi_ + qq) * AT_VSTR + (4 * (x ^ qq) + 2 * (g16 & 1) + (pp >> 1)) * 16 + (pp & 1) * 8;
        }
    }
    dma(0, 0); asm volatile("s_waitcnt vmcnt(0)" ::: "memory"); __syncthreads();
    for (int kt = 0; kt < nkt; ++kt) {
        const bool more = (kt + 1 < nkt);
        if (more) dma(kt + 1, (kt + 1) & 1);
        LAS unsigned char* Kl = ldsl + (kt & 1) * STAGE; LAS unsigned char* Vl = Kl + 64 * C::KSTR;
        const bool active = kt < wnkt;
        if (active) {
            const int k0i = kt * 64;
#pragma unroll
            for (int kb = 0; kb < 2; ++kb) {
                if (kb == 1 && k0i + 32 > qw + 31) break;
                f32x16 s0;
#pragma unroll
                for (int i = 0; i < 16; ++i) s0[i] = 0.f;
                {
                    bf16x8 kf[2][4];
                    const LAS unsigned char* Kb = Kl + kb * 32 * C::KSTR;
#pragma unroll
                    for (int x = 0; x < 4; ++x) kf[0][x] = (PROBE == 3) ? q[x] : *(const LAS bf16x8*)(Kb + koff[x]);
#pragma unroll
                    for (int g = 0; g < C::NKS / 4; ++g) {
                        if (g + 1 < C::NKS / 4) {
#pragma unroll
                            for (int x = 0; x < 4; ++x) kf[(g + 1) & 1][x] = (PROBE == 3) ? q[x] : *(const LAS bf16x8*)(Kb + koff[x] + (g + 1) * 128);
                        }
                        __builtin_amdgcn_sched_barrier(0);
#pragma unroll
                        for (int x = 0; x < 4; ++x) { if (PROBE == 2) { s0[x] += __builtin_bit_cast(float, (int)kf[g & 1][x][0]); } else s0 = __builtin_amdgcn_mfma_f32_32x32x16_bf16(kf[g & 1][x], q[4 * g + x], s0, 0, 0, 0); }
                        __builtin_amdgcn_sched_barrier(0);
                    }
                }
                if (k0i + 32 * kb + 31 > qw) {
                    const int qi = qw + r32;
#pragma unroll
                    for (int i = 0; i < 16; ++i) { const int key = k0i + 32 * kb + crow(i, hi_); if (key > qi) s0[i] = -INFINITY; }
                }
                float tmax = s0[0];
#pragma unroll
                for (int i = 1; i < 16; ++i) if (PROBE != 1) tmax = fmaxf(tmax, s0[i]);
                tmax = pair_max(tmax);
                const float mn0 = fmaxf(mrun, tmax);
                const bool upd = (mn0 - mrun) * Cs > 8.f;
                const float mn = upd ? mn0 : mrun;
                const float alpha = upd ? __builtin_amdgcn_exp2f((mrun - mn) * Cs) : 1.f;
                mrun = mn;
                const float mnC = -mn * Cs; float ps = 0.f;
#pragma unroll
                for (int i = 0; i < 16; ++i) { if (PROBE != 1) { s0[i] = __builtin_amdgcn_exp2f(fmaf(s0[i], Cs, mnC)); ps += s0[i]; } }
                lsum = lsum * alpha + ps;
                if (!__all(alpha == 1.f)) {
#pragma unroll
                    for (int d = 0; d < 4; ++d)
#pragma unroll
                        for (int i = 0; i < 16; ++i) o[d][i] *= alpha;
                }
#pragma unroll
                for (int s2 = 0; s2 < 2; ++s2) {
                    v4u w; w.x = pk2(s0[8 * s2 + 0], s0[8 * s2 + 1]); w.y = pk2(s0[8 * s2 + 2], s0[8 * s2 + 3]); w.z = pk2(s0[8 * s2 + 4], s0[8 * s2 + 5]); w.w = pk2(s0[8 * s2 + 6], s0[8 * s2 + 7]);
                    const bf16x8 pb = *reinterpret_cast<bf16x8*>(&w);
                    const int s = 2 * kb + s2;
                    s16x4 lo[4], hh[4];
                    if (PROBE == 3) {
#pragma unroll
                        for (int d = 0; d < 4; ++d) { lo[d] = (s16x4){pb[0], pb[1], pb[2], pb[3]}; hh[d] = (s16x4){pb[4], pb[5], pb[6], pb[7]}; }
                    } else {
#pragma unroll
                    for (int d = 0; d < 4; ++d) {
                        asm volatile("ds_read_b64_tr_b16 %0, %1 offset:%2" : "=v"(lo[d]) : "v"((unsigned)(size_t)Vl + voff[d]), "i"((16 * s) * AT_VSTR));
                        asm volatile("ds_read_b64_tr_b16 %0, %1 offset:%2" : "=v"(hh[d]) : "v"((unsigned)(size_t)Vl + voff[d]), "i"((16 * s + 8) * AT_VSTR));
                    }
                    asm volatile("s_waitcnt lgkmcnt(0)" : "+v"(lo[0]), "+v"(lo[1]), "+v"(lo[2]), "+v"(lo[3]), "+v"(hh[0]), "+v"(hh[1]), "+v"(hh[2]), "+v"(hh[3]));
                    }
#pragma unroll
                    for (int d = 0; d < 4; ++d) {
                        const bf16x8 va = (bf16x8){lo[d][0], lo[d][1], lo[d][2], lo[d][3], hh[d][0], hh[d][1], hh[d][2], hh[d][3]};
                        if (PROBE == 2) o[d][0] += __builtin_bit_cast(float, (int)va[0] + (int)pb[0]); else o[d] = __builtin_amdgcn_mfma_f32_32x32x16_bf16(va, pb, o[d], 0, 0, 0);
                    }
                }
            }
        }
        asm volatile("s_waitcnt vmcnt(0)" ::: "memory");
        __syncthreads();
    }
    lsum = pair_sum(lsum);
    const float linv = 1.f / lsum;
    bf16* mixed = (bf16*)(a->ws + WS_MIXED);
    const int tid2 = (int)lane_id_now();
    const int lane = tid2 & 63, hi = lane >> 5;
    const size_t tq = (size_t)b * S_ + qw + (lane & 31);
    if (TYPE == 0) {
        const bf16* gp = proj + tq * LDP + C_GATE + hd * 128; bf16* op = mixed + tq * D_ + hd * 128;
        v2u gws[4][4];
#pragma unroll
        for (int d = 0; d < 4; ++d)
#pragma unroll
            for (int ig = 0; ig < 4; ++ig) gws[d][ig] = *(const v2u*)(gp + 32 * d + 8 * ig + 4 * hi);
#pragma unroll
        for (int d = 0; d < 4; ++d)
#pragma unroll
            for (int ig = 0; ig < 4; ++ig) { const int dv = 32 * d + 8 * ig + 4 * hi; const v2u gw = gws[d][ig];
                v2u w; w.x = pk2(o[d][4 * ig + 0] * linv * siluf_(bflo(gw.x)), o[d][4 * ig + 1] * linv * siluf_(bfhi(gw.x)));
                w.y = pk2(o[d][4 * ig + 2] * linv * siluf_(bflo(gw.y)), o[d][4 * ig + 3] * linv * siluf_(bfhi(gw.y)));
                *(v2u*)(op + dv) = w; }
    } else {
        float* X = (float*)lds;
        if (wid >= 4) {
#pragma unroll
            for (int d = 0; d < 4; ++d)
#pragma unroll
                for (int i = 0; i < 16; ++i) X[(((wid - 4) * 4 + d) * 16 + i) * 64 + lane] = o[d][i] * linv;
        }
        __syncthreads();
        if (wid < 4) {
            float ss = 0.f;
#pragma unroll
            for (int d = 0; d < 4; ++d)
#pragma unroll
                for (int i = 0; i < 16; ++i) { const float v = o[d][i] * linv - lam * X[((wid * 4 + d) * 16 + i) * 64 + lane]; o[d][i] = v; ss += v * v; }
            ss = pair_sum(ss);
            const float rstd = (1.f - lam_init) / sqrtf(ss * (1.f / 128.f) + 1e-5f);
            const float* sg = (const float*)a->in[I_SUBG] + l * 128;
            const bf16* gp = proj + tq * LDP + C_GATE + 1536 + hd * 128; bf16* op = mixed + tq * D_ + 1536 + hd * 128;
            v2u gws[4][4]; f32x4 sgs[4][4];
#pragma unroll
            for (int d = 0; d < 4; ++d)
#pragma unroll
                for (int ig = 0; ig < 4; ++ig) { gws[d][ig] = *(const v2u*)(gp + 32 * d + 8 * ig + 4 * hi); sgs[d][ig] = *(const f32x4*)(sg + 32 * d + 8 * ig + 4 * hi); }
#pragma unroll
            for (int d = 0; d < 4; ++d)
#pragma unroll
                for (int ig = 0; ig < 4; ++ig) { const int dv = 32 * d + 8 * ig + 4 * hi; const v2u gw = gws[d][ig]; const f32x4 sgv = sgs[d][ig];
                    v2u w; w.x = pk2(o[d][4 * ig + 0] * rstd * sgv.x * siluf_(bflo(gw.x)), o[d][4 * ig + 1] * rstd * sgv.y * siluf_(bfhi(gw.x)));
                    w.y = pk2(o[d][4 * ig + 2] * rstd * sgv.z * siluf_(bflo(gw.y)), o[d][4 * ig + 3] * rstd * sgv.w * siluf_(bfhi(gw.y)));
                    *(v2u*)(op + dv) = w; }
        }
        __syncthreads();
    }
}
constexpr int CK_MA = 0, CK_MR = 4608, CK_MB = 9216, CK_MK = 13824, CK_MV = 18432, CK_MBH = 23040, CK_MKH = 27648, CK_LAB = 32256, CK_Y2 = 36864,
              CK_MRB = 45568, CK_MRK = 48128, CK_XT = 50688, CK_GT = 60928, CK_TOT = 61184, CK_BYTES = 65536;
constexpr int CK_ROW = 144, CK_TROW = 80, CK_Y2ROW = 272, CK_AFROW = 256;
constexpr size_t WS_QF = 660 * MiB;
constexpr size_t WS_CF = 724 * MiB;

__device__ __forceinline__ f32x16 ck_prod(const LAS unsigned char* LA, const LAS unsigned char* LB, int lane) {
    f32x16 acc;
#pragma unroll
    for (int i = 0; i < 16; ++i) acc[i] = 0.f;
    const int ro = (lane & 31) * CK_ROW + (lane >> 5) * 16;
#pragma unroll
    for (int ks = 0; ks < 4; ++ks) acc = __builtin_amdgcn_mfma_f32_32x32x16_bf16(*(const LAS bf16x8*)(LA + ro + ks * 32), *(const LAS bf16x8*)(LB + ro + ks * 32), acc, 0, 0, 0);
    return acc;
}
template <bool NAT> __device__ __forceinline__ bf16x8 ck_tr(LAS unsigned char* base, int s0, int col0, int lane) {
    const int g16 = lane >> 4, i16 = lane & 15, q = i16 >> 2, p = i16 & 3, hi = lane >> 5;
    const int r0 = NAT ? (s0 + 8 * hi + q) : (s0 + 4 * hi + q), r1 = NAT ? r0 + 4 : r0 + 8;
    const int co = (col0 + 16 * (g16 & 1) + 4 * p) * 2;
    const s16x4 lo = __builtin_amdgcn_ds_read_tr16_b64_v4i16((LAS s16x4*)(base + r0 * CK_ROW + co));
    const s16x4 hh = __builtin_amdgcn_ds_read_tr16_b64_v4i16((LAS s16x4*)(base + r1 * CK_ROW + co));
    return (bf16x8){lo[0], lo[1], lo[2], lo[3], hh[0], hh[1], hh[2], hh[3]};
}
__device__ __forceinline__ bf16x8 pack_bf8(const f32x16& x, int o) { v4u w; w.x = pk2(x[o], x[o + 1]); w.y = pk2(x[o + 2], x[o + 3]); w.z = pk2(x[o + 4], x[o + 5]); w.w = pk2(x[o + 6], x[o + 7]); return *reinterpret_cast<bf16x8*>(&w); }

struct CkPre { v4u r, k, v, kk, al, ee; };
__device__ __forceinline__ void ck_prefetch(AP a, int u, const int tid_, CkPre& p) {
    int tid = tid_; asm volatile("" : "+v"(tid));
    const int hp = u & 3, ch = (u >> 2) & 127, b = u >> 9, g = tid >> 8, t2 = tid & 255, st = t2 >> 3, cg = t2 & 7, hd = 2 * hp + g;
    const bf16* rw = (const bf16*)(a->ws + WS_RW) + ((size_t)b * S_ + (size_t)ch * 32 + st) * 512 + hd * 64 + cg * 8;
    p.r = *(const v4u*)(rw + 0 * RW_STRIDE); p.k = *(const v4u*)(rw + 1 * RW_STRIDE); p.v = *(const v4u*)(rw + 2 * RW_STRIDE);
    p.kk = *(const v4u*)(rw + 3 * RW_STRIDE); p.al = *(const v4u*)(rw + 4 * RW_STRIDE); p.ee = *(const v4u*)(rw + 5 * RW_STRIDE);
}
struct QTicket;
__device__ __forceinline__ int q_next(QTicket& t, unsigned* head, unsigned limit, volatile LAS unsigned* slot, int wave_idx);
__device__ __forceinline__ int rwkv_chunk_unit(AP a, int l, unsigned char* lds, int u, const int tid_, const bool dry, CkPre& pre, QTicket& qt, unsigned* qhead, unsigned qlimit, volatile LAS unsigned* qslot, int wave_s) {
    int tid = tid_; asm volatile("" : "+v"(tid));
    const int hp = u & 3, ch = (u >> 2) & 127, b = u >> 9;
    const int g = tid >> 8, t2 = tid & 255, st = t2 >> 3, cg = t2 & 7, hd = 2 * hp + g, w4 = __builtin_amdgcn_readfirstlane((tid >> 6) & 3), lane = tid & 63, hi = lane >> 5, r32 = lane & 31;
    LAS unsigned char* L = (LAS unsigned char*)lds + g * CK_BYTES;
    bf16* rw = (bf16*)(a->ws + WS_RW);
    const size_t tok0 = (size_t)b * S_ + (size_t)ch * 32, chid = ((size_t)b * 128 + ch) * 8 + hd;
    {   const size_t o = (tok0 + st) * 512 + hd * 64 + cg * 8;
        float r[8], k[8], kk[8], al[8], ee[8];
        unpack8(pre.r, r); unpack8(pre.k, k); unpack8(pre.kk, kk); unpack8(pre.al, al); unpack8(pre.ee, ee);
        const v4u vraw = pre.v;
        float inc[8];
#pragma unroll
        for (int e = 0; e < 8; ++e) { float x = ee[e];
#pragma unroll
            for (int d = 8; d < 64; d <<= 1) { const float up = shfl_up_l(x, d, lane); if (lane >= d) x += up; }
            inc[e] = x; }
        LAS float* TOT = (LAS float*)(L + CK_TOT);
        if ((lane >> 3) == 7) { *(LAS f32x4*)(TOT + w4 * 64 + cg * 8) = (f32x4){inc[0], inc[1], inc[2], inc[3]}; *(LAS f32x4*)(TOT + w4 * 64 + cg * 8 + 4) = (f32x4){inc[4], inc[5], inc[6], inc[7]}; }
        __syncthreads();
        float lamp[8], lamT[8];
#pragma unroll
        for (int e = 0; e < 8; ++e) { lamp[e] = inc[e] - ee[e]; lamT[e] = 0.f; }
#pragma unroll
        for (int w2 = 0; w2 < 4; ++w2) { const f32x4 t0 = *(const LAS f32x4*)(TOT + w2 * 64 + cg * 8), t1 = *(const LAS f32x4*)(TOT + w2 * 64 + cg * 8 + 4);
#pragma unroll
            for (int e = 0; e < 4; ++e) { lamT[e] += t0[e]; lamT[4 + e] += t1[e]; if (w2 < w4) { lamp[e] += t0[e]; lamp[4 + e] += t1[e]; } } }
        float at[8], rt[8], bt[8], kt[8], bh[8], kh[8];
#pragma unroll
        for (int e = 0; e < 8; ++e) { const float lc = lamp[e] + ee[e]; const float gp = __expf(-lamp[e]), gi = __expf(lc), gcur = __expf(-lc), gend = __expf(lc - lamT[e]);
            const float bv = kk[e] * al[e]; at[e] = -kk[e] * gp; rt[e] = r[e] * gcur; bt[e] = bv * gi; kt[e] = k[e] * gi; bh[e] = bv * gend; kh[e] = k[e] * gend; }
        const int ro = st * CK_ROW + cg * 16;
        *(LAS v4u*)(L + CK_MA + ro) = pack8(at); *(LAS v4u*)(L + CK_MR + ro) = pack8(rt); *(LAS v4u*)(L + CK_MB + ro) = pack8(bt); *(LAS v4u*)(L + CK_MK + ro) = pack8(kt);
        *(LAS v4u*)(L + CK_MV + ro) = vraw; *(LAS v4u*)(L + CK_MBH + ro) = pack8(bh); *(LAS v4u*)(L + CK_MKH + ro) = pack8(kh);
        LAS float* AF = (LAS float*)(L + CK_XT + st * CK_AFROW + cg * 32);
        *(LAS f32x4*)AF = (f32x4){at[0], at[1], at[2], at[3]}; *(LAS f32x4*)(AF + 4) = (f32x4){at[4], at[5], at[6], at[7]};
        if (st == 31) { float gT[8];
#pragma unroll
            for (int e = 0; e < 8; ++e) gT[e] = __expf(-lamT[e]);
            LAS float* G = (LAS float*)(L + CK_GT) + cg * 8; *(LAS f32x4*)G = (f32x4){gT[0], gT[1], gT[2], gT[3]}; *(LAS f32x4*)(G + 4) = (f32x4){gT[4], gT[5], gT[6], gT[7]};
            float* gg = (float*)(a->ws + WS_RWGT) + chid * 64 + cg * 8; *(f32x4*)gg = (f32x4){gT[0], gT[1], gT[2], gT[3]}; *(f32x4*)(gg + 4) = (f32x4){gT[4], gT[5], gT[6], gT[7]}; }
    }
    __syncthreads();
    if (w4 == 0) {
        const f32x16 acc = ck_prod(L + CK_MA, L + CK_MB, lane);
#pragma unroll
        for (int m = 0; m < 4; ++m) { const int t0 = 8 * m + 4 * hi;
            *(LAS f32x4*)(L + CK_LAB + r32 * CK_ROW + t0 * 4) = (f32x4){(r32 < t0) ? acc[4 * m] : 0.f, (r32 < t0 + 1) ? acc[4 * m + 1] : 0.f, (r32 < t0 + 2) ? acc[4 * m + 2] : 0.f, (r32 < t0 + 3) ? acc[4 * m + 3] : 0.f}; }
    } else if (w4 == 1) {
        f32x16 acc = ck_prod(L + CK_MK, L + CK_MA, lane);
#pragma unroll
        for (int i = 0; i < 16; ++i) if (!(crow(i, hi) < r32)) acc[i] = 0.f;
        const bf16x8 pb0 = pack_bf8(acc, 0), pb1 = pack_bf8(acc, 8);
#pragma unroll
        for (int vb = 0; vb < 2; ++vb) { f32x16 y;
#pragma unroll
            for (int i = 0; i < 16; ++i) y[i] = 0.f;
            y = __builtin_amdgcn_mfma_f32_32x32x16_bf16(ck_tr<false>(L + CK_MV, 0, 32 * vb, lane), pb0, y, 0, 0, 0);
            y = __builtin_amdgcn_mfma_f32_32x32x16_bf16(ck_tr<false>(L + CK_MV, 16, 32 * vb, lane), pb1, y, 0, 0, 0);
#pragma unroll
            for (int m = 0; m < 4; ++m) *(LAS f32x4*)(L + CK_Y2 + r32 * CK_Y2ROW + (32 * vb + 8 * m + 4 * hi) * 4) = (f32x4){y[4 * m], y[4 * m + 1], y[4 * m + 2], y[4 * m + 3]}; }
    } else {
        const f32x16 acc = ck_prod(L + (w4 == 2 ? CK_MB : CK_MK), L + CK_MR, lane);
        LAS unsigned char* D = L + (w4 == 2 ? CK_MRB : CK_MRK) + r32 * CK_TROW;
#pragma unroll
        for (int m = 0; m < 4; ++m) { float x[4];
#pragma unroll
            for (int e = 0; e < 4; ++e) x[e] = (8 * m + 4 * hi + e <= r32) ? acc[4 * m + e] : 0.f;
            v2u w; w.x = pk2(x[0], x[1]); w.y = pk2(x[2], x[3]); *(LAS v2u*)(D + (8 * m + 4 * hi) * 2) = w; }
    }
    __syncthreads();
    float x[32];
#pragma unroll
    for (int t = 0; t < 32; ++t) x[t] = 0.f;
    if (w4 < 2) {
        const LAS unsigned char* rhs = (w4 == 0) ? (L + CK_XT + lane * 4) : (L + CK_Y2 + lane * 4);
        const int rstride = (w4 == 0) ? CK_AFROW : CK_Y2ROW;
#pragma unroll
        for (int t = 0; t < 32; ++t) x[t] = *(const LAS float*)(rhs + t * rstride);
#pragma unroll
        for (int s_ = 0; s_ < 31; ++s_) {
#pragma unroll
            for (int t4 = (s_ + 1) / 4; t4 < 8; ++t4) { const f32x4 lv = *(const LAS f32x4*)(L + CK_LAB + s_ * CK_ROW + t4 * 16);
#pragma unroll
                for (int e = 0; e < 4; ++e) if (4 * t4 + e > s_) x[4 * t4 + e] += lv[e] * x[s_]; }
        }
    }
    __syncthreads();
    if (w4 < 2) { LAS unsigned char* D = L + CK_XT + (w4 * 64 + lane) * CK_TROW;
#pragma unroll
        for (int q = 0; q < 4; ++q) { v4u w; w.x = pk2(x[8 * q], x[8 * q + 1]); w.y = pk2(x[8 * q + 2], x[8 * q + 3]); w.z = pk2(x[8 * q + 4], x[8 * q + 5]); w.w = pk2(x[8 * q + 6], x[8 * q + 7]); *(LAS v4u*)(D + q * 16) = w; } }
    const int nu = q_next(qt, qhead, qlimit, qslot, wave_s);
    if (nu < (int)qlimit) ck_prefetch(a, nu, tid, pre);
    int lane4 = tid & 63; asm volatile("" : "+v"(lane4));
    const int hi4 = lane4 >> 5, r4 = lane4 & 31;
    const int ko = hi4 * 16;
    if (w4 == 0) {
        bf16* rh = rw + 3 * RW_STRIDE;
#pragma unroll
        for (int kb = 0; kb < 2; ++kb) { f32x16 acc;
#pragma unroll
            for (int i = 0; i < 16; ++i) acc[i] = 0.f;
#pragma unroll
            for (int ks = 0; ks < 2; ++ks) acc = __builtin_amdgcn_mfma_f32_32x32x16_bf16(*(const LAS bf16x8*)(L + CK_XT + (32 * kb + r4) * CK_TROW + ks * 32 + ko), *(const LAS bf16x8*)(L + CK_MRB + r4 * CK_TROW + ks * 32 + ko), acc, 0, 0, 0);
#pragma unroll
            for (int m = 0; m < 4; ++m) { const int kc = 32 * kb + 8 * m + 4 * hi4; const v2u rr = *(const LAS v2u*)(L + CK_MR + r4 * CK_ROW + kc * 2);
                v2u w; w.x = pk2(acc[4 * m] + bflo(rr.x), acc[4 * m + 1] + bfhi(rr.x)); w.y = pk2(acc[4 * m + 2] + bflo(rr.y), acc[4 * m + 3] + bfhi(rr.y));
                if (!dry) *(v2u*)(rh + (tok0 + r4) * 512 + hd * 64 + kc) = w; else asm volatile("" :: "v"(w.x), "v"(w.y)); } }
    } else if (w4 == 1) {
        float* rwo = (float*)(a->ws + WS_RWO);
#pragma unroll
        for (int vb = 0; vb < 2; ++vb) { f32x16 acc;
#pragma unroll
            for (int i = 0; i < 16; ++i) acc[i] = 0.f;
#pragma unroll
            for (int ks = 0; ks < 2; ++ks) {
                acc = __builtin_amdgcn_mfma_f32_32x32x16_bf16(*(const LAS bf16x8*)(L + CK_XT + (64 + 32 * vb + r4) * CK_TROW + ks * 32 + ko), *(const LAS bf16x8*)(L + CK_MRB + r4 * CK_TROW + ks * 32 + ko), acc, 0, 0, 0);
                acc = __builtin_amdgcn_mfma_f32_32x32x16_bf16(ck_tr<true>(L + CK_MV, 16 * ks, 32 * vb, lane4), *(const LAS bf16x8*)(L + CK_MRK + r4 * CK_TROW + ks * 32 + ko), acc, 0, 0, 0); }
#pragma unroll
            for (int m = 0; m < 4; ++m) *(f32x4*)(rwo + (tok0 + r4) * 512 + hd * 64 + 32 * vb + 8 * m + 4 * hi4) = (f32x4){acc[4 * m], acc[4 * m + 1], acc[4 * m + 2], acc[4 * m + 3]}; }
    } else if (w4 == 2) {
        bf16* cf = (bf16*)(a->ws + WS_CF) + chid * 4096;
#pragma unroll
        for (int k1b = 0; k1b < 2; ++k1b)
#pragma unroll
            for (int k2b = 0; k2b < 2; ++k2b) { f32x16 acc;
#pragma unroll
                for (int i = 0; i < 16; ++i) acc[i] = 0.f;
#pragma unroll
                for (int ks = 0; ks < 2; ++ks) acc = __builtin_amdgcn_mfma_f32_32x32x16_bf16(*(const LAS bf16x8*)(L + CK_XT + (32 * k1b + r4) * CK_TROW + ks * 32 + ko), ck_tr<true>(L + CK_MBH, 16 * ks, 32 * k2b, lane4), acc, 0, 0, 0);
#pragma unroll
                for (int ks = 0; ks < 2; ++ks) { const bf16x8 f = pack_bf8(acc, 8 * ks); *(bf16x8*)(cf + (size_t)(((k1b * 2 + k2b) * 2 + ks) * 64 + lane4) * 8) = f; } }
    } else {
        float* qf = (float*)(a->ws + WS_QF) + chid * 4096;
#pragma unroll
        for (int kb = 0; kb < 2; ++kb)
#pragma unroll
            for (int vb = 0; vb < 2; ++vb) { f32x16 acc;
#pragma unroll
                for (int i = 0; i < 16; ++i) acc[i] = 0.f;
#pragma unroll
                for (int ks = 0; ks < 2; ++ks) {
                    acc = __builtin_amdgcn_mfma_f32_32x32x16_bf16(ck_tr<true>(L + CK_MBH, 16 * ks, 32 * kb, lane4), *(const LAS bf16x8*)(L + CK_XT + (64 + 32 * vb + r4) * CK_TROW + ks * 32 + ko), acc, 0, 0, 0);
                    acc = __builtin_amdgcn_mfma_f32_32x32x16_bf16(ck_tr<true>(L + CK_MKH, 16 * ks, 32 * kb, lane4), ck_tr<true>(L + CK_MV, 16 * ks, 32 * vb, lane4), acc, 0, 0, 0); }
#pragma unroll
                for (int m = 0; m < 4; ++m) *(f32x4*)(qf + (size_t)(((kb * 2 + vb) * 4 + m) * 64 + lane4) * 4) = (f32x4){acc[4 * m], acc[4 * m + 1], acc[4 * m + 2], acc[4 * m + 3]}; }
    }
    __syncthreads();
    return nu;
}

constexpr int SC_Q = 0, SC_C = 16384, SC_R = 24576, SC_G = 28672, SC_SLOT = 29696, SC_NSLOT = 4;
constexpr size_t WS_ZB = 756 * MiB;
__device__ __forceinline__ void rwkv_scan_unit(AP a, unsigned char* lds, int u, const int tid, const bool dry, unsigned* done) {
    const int wid = __builtin_amdgcn_readfirstlane(tid >> 6), lane = tid & 63, hi = lane >> 5, r32 = lane & 31;
    const int b = u >> 3, hd = u & 7;
    LAS unsigned char* ldsl = (LAS unsigned char*)lds;
    const char* rhb = (const char*)((const bf16*)(a->ws + WS_RW) + 3 * RW_STRIDE); float* zb = (float*)(a->ws + WS_ZB);
    const char* qfb = (const char*)(a->ws + WS_QF); const char* cfb = (const char*)(a->ws + WS_CF); const char* gtb = (const char*)(a->ws + WS_RWGT);
    const int mj = (wid - 2) >> 1, mm = wid & 1;
    auto move = [&](int ch) {
        const size_t chid = ((size_t)b * 128 + ch) * 8 + hd; const int so = (ch & 3) * SC_SLOT;
        if (mm == 0) {
#pragma unroll
            for (int i = 0; i < 16; ++i) __builtin_amdgcn_global_load_lds((const unsigned*)(qfb + chid * 16384 + i * 1024 + lane * 16), (LAS unsigned*)(ldsl + so + SC_Q + i * 1024), 16, 0, 0);
        } else {
#pragma unroll
            for (int i = 0; i < 8; ++i) __builtin_amdgcn_global_load_lds((const unsigned*)(cfb + chid * 8192 + i * 1024 + lane * 16), (LAS unsigned*)(ldsl + so + SC_C + i * 1024), 16, 0, 0);
            const size_t tok0 = (size_t)b * S_ + (size_t)ch * 32;
#pragma unroll
            for (int i = 0; i < 4; ++i) __builtin_amdgcn_global_load_lds((const unsigned*)(rhb + ((tok0 + i * 8 + (lane >> 3)) * 512 + hd * 64) * 2 + (lane & 7) * 16), (LAS unsigned*)(ldsl + so + SC_R + i * 1024), 16, 0, 0);
            __builtin_amdgcn_global_load_lds((const unsigned*)(gtb + (chid - (hd & 3)) * 256 + lane * 16), (LAS unsigned*)(ldsl + so + SC_G), 16, 0, 0);
        }
    };
    f32x16 st0, st1;
#pragma unroll
    for (int i = 0; i < 16; ++i) { st0[i] = 0.f; st1[i] = 0.f; }
    if (wid >= 2) { move(mj); if (mj == 0) asm volatile("s_waitcnt vmcnt(0)" ::: "memory"); }
    __syncthreads();
    for (int ch = 0; ch < 128; ++ch) {
        if (wid >= 2) {
            if (ch % 3 == mj) { if (ch + 3 < 128) move(ch + 3); }
            if ((ch + 1) % 3 == mj) asm volatile("s_waitcnt vmcnt(0)" ::: "memory");
        } else {
            const int vb = wid; const LAS unsigned char* P = ldsl + (ch & 3) * SC_SLOT;
            f32x16 n0, n1;
#pragma unroll
            for (int m = 0; m < 4; ++m) {
                const f32x4 q0 = *(const LAS f32x4*)(P + SC_Q + (((0 * 2 + vb) * 4 + m) * 64 + lane) * 16), q1 = *(const LAS f32x4*)(P + SC_Q + (((1 * 2 + vb) * 4 + m) * 64 + lane) * 16);
                const f32x4 g0 = *(const LAS f32x4*)(P + SC_G + (hd & 3) * 256 + (8 * m + 4 * hi) * 4), g1 = *(const LAS f32x4*)(P + SC_G + (hd & 3) * 256 + (32 + 8 * m + 4 * hi) * 4);
#pragma unroll
                for (int e = 0; e < 4; ++e) { n0[4 * m + e] = q0[e] + g0[e] * st0[4 * m + e]; n1[4 * m + e] = q1[e] + g1[e] * st1[4 * m + e]; }
            }
            bf16x8 sh[2][2], sl[2][2];
#pragma unroll
            for (int ks = 0; ks < 2; ++ks) {
                sh[0][ks] = pack_bf8(st0, 8 * ks); sh[1][ks] = pack_bf8(st1, 8 * ks);
                f32x16 d0, d1;
#pragma unroll
                for (int j = 0; j < 8; ++j) { const unsigned short h0 = (unsigned short)sh[0][ks][j], h1 = (unsigned short)sh[1][ks][j];
                    d0[j] = st0[8 * ks + j] - bf1(h0); d1[j] = st1[8 * ks + j] - bf1(h1); }
                sl[0][ks] = pack_bf8(d0, 0); sl[1][ks] = pack_bf8(d1, 0);
            }
            f32x16 z;
#pragma unroll
            for (int i = 0; i < 16; ++i) z[i] = 0.f;
#pragma unroll
            for (int kb = 0; kb < 2; ++kb)
#pragma unroll
                for (int ks = 0; ks < 2; ++ks) {
                    const bf16x8 c0 = *(const LAS bf16x8*)(P + SC_C + (((kb * 2 + 0) * 2 + ks) * 64 + lane) * 16), c1 = *(const LAS bf16x8*)(P + SC_C + (((kb * 2 + 1) * 2 + ks) * 64 + lane) * 16);
                    n0 = __builtin_amdgcn_mfma_f32_32x32x16_bf16(c0, sh[kb][ks], n0, 0, 0, 0); n0 = __builtin_amdgcn_mfma_f32_32x32x16_bf16(c0, sl[kb][ks], n0, 0, 0, 0);
                    n1 = __builtin_amdgcn_mfma_f32_32x32x16_bf16(c1, sh[kb][ks], n1, 0, 0, 0); n1 = __builtin_amdgcn_mfma_f32_32x32x16_bf16(c1, sl[kb][ks], n1, 0, 0, 0);
                    const v2u ra = *(const LAS v2u*)(P + SC_R + r32 * 128 + (32 * kb + 16 * ks + 4 * hi) * 2), rb2 = *(const LAS v2u*)(P + SC_R + r32 * 128 + (32 * kb + 16 * ks + 8 + 4 * hi) * 2);
                    v4u w; w.x = ra.x; w.y = ra.y; w.z = rb2.x; w.w = rb2.y; const bf16x8 rb = *reinterpret_cast<bf16x8*>(&w);
                    z = __builtin_amdgcn_mfma_f32_32x32x16_bf16(sh[kb][ks], rb, z, 0, 0, 0); z = __builtin_amdgcn_mfma_f32_32x32x16_bf16(sl[kb][ks], rb, z, 0, 0, 0);
                }
            const size_t tok = (size_t)b * S_ + (size_t)ch * 32 + r32;
#pragma unroll
            for (int m = 0; m < 4; ++m) { if (!dry) *(f32x4*)(zb + tok * 512 + hd * 64 + 32 * vb + 8 * m + 4 * hi) = (f32x4){z[4 * m], z[4 * m + 1], z[4 * m + 2], z[4 * m + 3]}; else asm volatile("" :: "v"(z[4 * m]), "v"(z[4 * m + 1]), "v"(z[4 * m + 2]), "v"(z[4 * m + 3])); }
            st0 = n0; st1 = n1;
        }
        __syncthreads();
    }
    asm volatile("s_waitcnt vmcnt(0)" ::: "memory"); __syncthreads();
    if (xb_thread0(wid)) { __builtin_amdgcn_fence(__ATOMIC_RELEASE, "agent"); asm volatile("s_waitcnt vmcnt(0)" ::: "memory"); (void)xb_add(done, 1u); }
}
__device__ __forceinline__ void s5_build_group(AP a, int l, int g, unsigned char* lds, const int tid) {
    float* PW = (float*)lds;
    float* BB = PW + 17 * 64 * 2;
    float* CC = BB + 64 * 16 * 2;
    float* KK = CC + 16 * 64 * 2;
    if (tid < 64) { const int p = tid; float ar, ai, lr, li; s5_ab(a, l, g, p, ar, ai, lr, li);
        const float den = lr * lr + li * li, nr = ar - 1.f, ni = ai, fre = (nr * lr + ni * li) / den, fim = (ni * lr - nr * li) / den;
        float pr = 1.f, pi = 0.f; asm volatile("" : "+v"(pr), "+v"(pi));
        for (int t = 0; t <= 16; ++t) { PW[(t * 64 + p) * 2] = pr; PW[(t * 64 + p) * 2 + 1] = pi; const float n0 = pr * ar - pi * ai, n1 = pr * ai + pi * ar; pr = n0; pi = n1; }
        const float* br = (const float*)a->in[I_S5BRE] + ((size_t)(l * 32 + g) * 64 + p) * 16; const float* bi = (const float*)a->in[I_S5BIM] + ((size_t)(l * 32 + g) * 64 + p) * 16;
        for (int c = 0; c < 16; ++c) { BB[(p * 16 + c) * 2] = fre * br[c] - fim * bi[c]; BB[(p * 16 + c) * 2 + 1] = fre * bi[c] + fim * br[c]; } }
    for (int i = tid; i < 1024; i += NTHR) { CC[i * 2] = ((const float*)a->in[I_S5CRE])[(size_t)(l * 32 + g) * 1024 + i]; CC[i * 2 + 1] = ((const float*)a->in[I_S5CIM])[(size_t)(l * 32 + g) * 1024 + i]; }
    __syncthreads();
    for (int e = tid; e < 4096; e += NTHR) { const int tau = e >> 8, c = (e >> 4) & 15, cp = e & 15; float acc = 0.f;
        for (int p = 0; p < 64; ++p) { const float cr = CC[(c * 64 + p) * 2], ci = CC[(c * 64 + p) * 2 + 1], pr = PW[(tau * 64 + p) * 2], pi = PW[(tau * 64 + p) * 2 + 1];
            const float xr = cr * pr - ci * pi, xi = cr * pi + ci * pr; acc += xr * BB[(p * 16 + cp) * 2] - xi * BB[(p * 16 + cp) * 2 + 1]; }
        KK[e] = acc; }
    __syncthreads();
    bf16* kz = (bf16*)(a->ws + WS_S5KZ) + (size_t)g * 256 * 384; bf16* w1 = (bf16*)(a->ws + WS_S5W1) + (size_t)g * 256 * 256;
    for (int i = tid; i < 256 * 48; i += NTHR) { const int n = i / 48, k0 = (i % 48) * 8, t = n >> 4, c = n & 15; float x[8];
#pragma unroll
        for (int j = 0; j < 8; ++j) { const int k = k0 + j;
            if (k < 256) { const int s = k >> 4, cp = k & 15; x[j] = (s <= t) ? KK[((t - s) * 16 + c) * 16 + cp] : 0.f; }
            else { const int p = (k - 256) & 63; const float cr = CC[(c * 64 + p) * 2], ci = CC[(c * 64 + p) * 2 + 1], pr = PW[((t + 1) * 64 + p) * 2], pi = PW[((t + 1) * 64 + p) * 2 + 1];
                x[j] = (k < 320) ? (cr * pr - ci * pi) : -(cr * pi + ci * pr); } }
        *(v4u*)(kz + (size_t)n * 384 + k0) = pack8(x); }
    for (int i = tid; i < 256 * 32; i += NTHR) { const int n = i >> 5, k0 = (i & 31) * 8; float x[8];
#pragma unroll
        for (int j = 0; j < 8; ++j) { const int k = k0 + j, s = k >> 4, cp = k & 15;
            if (n < 128) { const int p = n & 63; const float pr = PW[((15 - s) * 64 + p) * 2], pi = PW[((15 - s) * 64 + p) * 2 + 1], br = BB[(p * 16 + cp) * 2], bi = BB[(p * 16 + cp) * 2 + 1];
                x[j] = (n < 64) ? (pr * br - pi * bi) : (pr * bi + pi * br); } else x[j] = 0.f; }
        *(v4u*)(w1 + (size_t)n * 256 + k0) = pack8(x); }
    __syncthreads();
}

struct OneUnit { int pm, pn; __device__ bool next(int i, pg8::Unit& u) const { if (i) return false; u.pm = pm; u.pn = pn; return true; } };
struct EpiS5E {
    static constexpr bool PERM = false, AFTER_DRAIN = true;
    __device__ __forceinline__ void after(const f32x4 (&acc)[2][2][4][2], const pg8::Unit&, int wr, int wc, int fr, int fq, LAS unsigned char* lds) const {
        const int row0 = wr * 64 + fr, col0 = wc * 32 + 4 * fq;
#pragma unroll
        for (int ai = 0; ai < 2; ++ai)
#pragma unroll
            for (int m = 0; m < 4; ++m)
#pragma unroll
                for (int n = 0; n < 2; ++n) *(LAS f32x4*)(lds + ((row0 + ai * 128 + m * 16) * 128 + col0 + n * 16) * 4) = acc[ai][0][m][n];
    }
};
struct EpiS5Y {
    static constexpr bool PERM = true, AFTER_DRAIN = false;
    const bf16* proj; const float* dvec; bf16* gact; int g, tokbase;
    __device__ __forceinline__ void operator()(const f32x4 (&acc)[2][2][4][2], const pg8::Unit& u, int wr, int wc, int fr, int fq) const {
        int fr_ = fr, fq_ = fq; asm volatile("" : "+v"(fr_), "+v"(fq_));
        const int r0 = wr * 64 + fr_, c0 = wc * 32 + 8 * fq_;
        float dv[2][8];
#pragma unroll
        for (int bj = 0; bj < 2; ++bj) { const int cc = (c0 + bj * 128) & 15; *(f32x4*)&dv[bj][0] = *(const f32x4*)(dvec + g * 16 + cc); *(f32x4*)&dv[bj][4] = *(const f32x4*)(dvec + g * 16 + cc + 4); }
#pragma unroll
        for (int ai = 0; ai < 2; ++ai) {
            v4u ur[4][2];
#pragma unroll
            for (int m = 0; m < 4; ++m)
#pragma unroll
                for (int bj = 0; bj < 2; ++bj) { const int r = r0 + ai * 128 + m * 16, cl = c0 + bj * 128, t = cl >> 4, cc = cl & 15; const size_t tok = (size_t)tokbase + 16 * r + t;
                    ur[m][bj] = *(const v4u*)(proj + tok * LDP + C_US5 + g * 16 + cc); }
#pragma unroll
            for (int m = 0; m < 4; ++m) { const int r = r0 + ai * 128 + m * 16;
#pragma unroll
                for (int bj = 0; bj < 2; ++bj) { const int cl = c0 + bj * 128, t = cl >> 4, cc = cl & 15; const size_t tok = (size_t)tokbase + 16 * r + t;
                    float uu[8], y[8]; unpack8(ur[m][bj], uu);
#pragma unroll
                    for (int e = 0; e < 8; ++e) y[e] = gelu_fast(acc[ai][bj][m][e >> 2][e & 3] + dv[bj][e] * uu[e]);
                    *(v4u*)(gact + tok * 512 + g * 16 + cc) = pack8(y); } }
        }
    }
};
constexpr int S5_SG_OFF = 132096;
__device__ __forceinline__ void s5_step_g1(AP a, unsigned char* lds, int u, const int tid) {
    pg8::Gemm gm{(const bf16*)(a->ws + WS_ACAT), (const bf16*)(a->ws + WS_S5W1), 32768, 8192, 256, 384, 256}; OneUnit S{u, u >> 2};
    EpiS5E E{}; pg8::gemm_phase<EpiS5E, OneUnit>((LAS unsigned char*)lds, gm, S, E, tid);
    __syncthreads();
}
__device__ __forceinline__ void s5_step_scan(AP a, int l, unsigned char* lds, int u, const int tid) {
    const int g = u >> 2;
    const int seg = tid >> 6, p = tid & 63; float ar, ai, lr, li; s5_ab(a, l, g, p, ar, ai, lr, li);
#pragma unroll
    for (int i = 0; i < 4; ++i) { const float n0 = ar * ar - ai * ai, n1 = 2.f * ar * ai; ar = n0; ai = n1; }
    const float* E = (const float*)lds + (seg * 32) * 128;
    float hr = 0.f, hi = 0.f;
#pragma unroll 8
    for (int r = 0; r < 32; ++r) { const float er = E[r * 128 + p], ei = E[r * 128 + 64 + p]; const float n0 = ar * hr - ai * hi + er, n1 = ar * hi + ai * hr + ei; hr = n0; hi = n1; }
    float* SG = (float*)(lds + S5_SG_OFF);
    SG[(seg * 64 + p) * 2] = hr; SG[(seg * 64 + p) * 2 + 1] = hi;
    __syncthreads();
    float br = ar, bi = ai;
#pragma unroll
    for (int i = 0; i < 5; ++i) { const float n0 = br * br - bi * bi, n1 = 2.f * br * bi; br = n0; bi = n1; }
    hr = 0.f; hi = 0.f;
    for (int j = 0; j < seg; ++j) { const float sr = SG[(j * 64 + p) * 2], si = SG[(j * 64 + p) * 2 + 1]; const float n0 = br * hr - bi * hi + sr, n1 = br * hi + bi * hr + si; hr = n0; hi = n1; }
    bf16* ac = (bf16*)(a->ws + WS_ACAT) + ((size_t)u * 256 + seg * 32) * 384 + 256;
#pragma unroll 8
    for (int r = 0; r < 32; ++r) { ac[r * 384 + p] = f2bf(hr); ac[r * 384 + 64 + p] = f2bf(hi);
        const float er = E[r * 128 + p], ei = E[r * 128 + 64 + p]; const float n0 = ar * hr - ai * hi + er, n1 = ar * hi + ai * hr + ei; hr = n0; hi = n1; }
    asm volatile("s_waitcnt vmcnt(0)" ::: "memory"); __syncthreads();
}
__device__ __forceinline__ void s5_step_g2(AP a, int l, unsigned char* lds, int u, const int tid) {
    const int g = u >> 2, b = u & 3;
    pg8::Gemm gm{(const bf16*)(a->ws + WS_ACAT), (const bf16*)(a->ws + WS_S5KZ), 32768, 8192, 384, 384, 384}; OneUnit S{u, g};
    EpiS5Y E{(const bf16*)(a->ws + WS_PROJ), (const float*)a->in[I_S5D] + l * 512, (bf16*)(a->ws + WS_GACT), g, b * S_};
    pg8::gemm_phase<EpiS5Y, OneUnit>((LAS unsigned char*)lds, gm, S, E, tid);
}
__device__ __forceinline__ void phase_rwkv_finish(AP a, int l, int m_lo, int m_hi, int wave, int lane) {
    const float* rwo = (const float*)(a->ws + WS_RWO);
    const bf16* rwv = (const bf16*)(a->ws + WS_RW) + 2 * RW_STRIDE; const bf16* proj = (const bf16*)(a->ws + WS_PROJ); bf16* mixed = (bf16*)(a->ws + WS_MIXED);
    const float* lg = (const float*)a->in[I_LNG] + l * 512 + lane * 8; const float* lb = (const float*)a->in[I_LNB] + l * 512 + lane * 8;
    const f32x4 g0 = *(const f32x4*)lg, g1 = *(const f32x4*)(lg + 4), b0 = *(const f32x4*)lb, b1 = *(const f32x4*)(lb + 4);
    const float* rkp = (const float*)a->in[I_RK] + l * 512 + lane * 8; const f32x4 rk0 = *(const f32x4*)rkp, rk1 = *(const f32x4*)(rkp + 4);
    constexpr int FB = 4;
    for (int m0 = m_lo + wave; m0 < m_hi; m0 += NWAVES * FB) {
        f32x4 ra[FB][2], za[FB][2]; v4u rr_[FB], kp_[FB], vv_[FB], gt_[FB];
#pragma unroll
        for (int t = 0; t < FB; ++t) { const int m = m0 + t * NWAVES; if (m < m_hi) { const size_t o = (size_t)m * 512 + lane * 8;
            ra[t][0] = *(const f32x4*)(rwo + o); ra[t][1] = *(const f32x4*)(rwo + o + 4);
            const float* zbp = (const float*)(a->ws + WS_ZB) + o; za[t][0] = *(const f32x4*)zbp; za[t][1] = *(const f32x4*)(zbp + 4);
            rr_[t] = *(const v4u*)(rwv - 2 * RW_STRIDE + o); kp_[t] = *(const v4u*)(rwv - RW_STRIDE + o); vv_[t] = *(const v4u*)(rwv + o);
            gt_[t] = *(const v4u*)(proj + (size_t)m * LDP + C_GATE + 1024 + lane * 8); } }
#pragma unroll
        for (int t = 0; t < FB; ++t) { const int m = m0 + t * NWAVES; if (m < m_hi) {
            const f32x4 o0 = ra[t][0] + za[t][0], o1 = ra[t][1] + za[t][1];
            const float mean = red8((o0.x + o0.y + o0.z + o0.w) + (o1.x + o1.y + o1.z + o1.w)) * (1.f / 64.f);
            const f32x4 d0 = o0 - mean, d1 = o1 - mean;
            const float var = red8((d0.x * d0.x + d0.y * d0.y + d0.z * d0.z + d0.w * d0.w) + (d1.x * d1.x + d1.y * d1.y + d1.z * d1.z + d1.w * d1.w)) * (1.f / 64.f);
            const float rstd = 1.f / sqrtf(var + 64e-5f);
            float v[8], gt[8], y[8], rr[8], kp[8];
            unpack8(rr_[t], rr); unpack8(kp_[t], kp);
            float bn = 0.f;
#pragma unroll
            for (int e = 0; e < 8; ++e) bn += rr[e] * kp[e] * (e < 4 ? rk0[e & 3] : rk1[e & 3]);
            bn = red8(bn);
            unpack8(vv_[t], v); unpack8(gt_[t], gt);
#pragma unroll
            for (int e = 0; e < 4; ++e) { y[e] = (d0[e] * rstd * g0[e] + b0[e] + bn * v[e]) * siluf_(gt[e]); y[4 + e] = (d1[e] * rstd * g1[e] + b1[e] + bn * v[4 + e]) * siluf_(gt[4 + e]); }
            *(v4u*)(mixed + (size_t)m * D_ + 1024 + lane * 8) = pack8(y); } }
    }
}

__device__ __forceinline__ int q_pop(unsigned* head, volatile LAS unsigned* slot, int wave_idx) {
    __syncthreads();
    if (xb_thread0(wave_idx)) *slot = __hip_atomic_fetch_add(head, 1u, __ATOMIC_RELAXED, __HIP_MEMORY_SCOPE_AGENT);
    __syncthreads();
    return (int)*slot;
}
struct QTicket { unsigned nxt; };
__device__ __forceinline__ QTicket q_first(unsigned* head, int wave_idx) { QTicket t; t.nxt = 0u;
    if (xb_thread0(wave_idx)) t.nxt = __hip_atomic_fetch_add(head, 1u, __ATOMIC_RELAXED, __HIP_MEMORY_SCOPE_AGENT);
    return t; }
__device__ __forceinline__ int q_next(QTicket& t, unsigned* head, unsigned limit, volatile LAS unsigned* slot, int wave_idx) {
    __syncthreads();
    if (xb_thread0(wave_idx)) { const unsigned cur = t.nxt; *slot = cur; if (cur < limit) t.nxt = __hip_atomic_fetch_add(head, 1u, __ATOMIC_RELAXED, __HIP_MEMORY_SCOPE_AGENT); }
    __syncthreads();
    return (int)*slot;
}
constexpr int PH_PER_L = 5, N_PHASES = 1 + L_ * PH_PER_L + 1;
template <int PATT> __device__ __forceinline__ void fwd_body(const Args& args0) {
    extern __shared__ __attribute__((aligned(16))) unsigned char lds[];
    const int tid0 = threadIdx.x;
    const int wave_s = __builtin_amdgcn_readfirstlane(tid0 >> 6);
    const int G = gridDim.x, bx = blockIdx.x;
#define SITE() AP args; { unsigned long long kp_ = (unsigned long long)__builtin_amdgcn_kernarg_segment_ptr(); asm volatile("" : "+s"(kp_)); args = (AP)kp_; } int tid; asm volatile("v_mbcnt_lo_u32_b32 %0, -1, 0\n\tv_mbcnt_hi_u32_b32 %0, -1, %0\n\tv_lshl_add_u32 %0, %1, 6, %0" : "=&v"(tid) : "s"(wave_s));     const int lane = tid & 63, wave = __builtin_amdgcn_readfirstlane(tid >> 6); const int gw = bx * NWAVES + wave, NGW = G * NWAVES; (void)lane; (void)gw; (void)NGW
    volatile LAS unsigned* MISC = (volatile LAS unsigned*)((LAS unsigned char*)lds + MISC_OFF);
    if (tid0 < 32) MISC[tid0] = 0u;
    __syncthreads();
    unsigned* ctl = (unsigned*)(args0.ws + WS_CTL);
    const bool one_launch = (args0.ph_hi - args0.ph_lo) > 1;
    XcdBarrier bar; bar.bar = ctl + CW_BAR; bar.x = 0; bar.st = nullptr; bar.wave = wave_s;
    if (one_launch) bar = xcd_barrier_post(ctl + CW_BAR, MISC + 8, wave_s);
    const int lo = args0.ph_lo, hi = args0.ph_hi;
#define IN(k) (lo <= (k) && (k) < hi)
#define SEAM(k) do { if (IN(k) && IN((k) + 1)) xcd_barrier(bar); } while (0)

    if (IN(0)) { SITE(); phase_convert(args, lds, gw, NGW, wave, lane); }
    SEAM(0);
    for (int l = 0; l < L_; ++l) {
        const int p0 = l * PH_PER_L;
        if (IN(p0 + 1)) { SITE();
            const bf16* xl = (const bf16*)args->out + (size_t)(l & 1) * M_ * D_;
            int bxl = bx; asm volatile("" : "+s"(bxl));
            pg8::Gemm g{xl, (const bf16*)(args->ws + WS_WIN) + (size_t)l * LDP * D_, M_, LDP, D_, D_, D_}; pg8::StaticOrder S; S.init(M_, LDP, G, bxl);
            const float* ssp = (const float*)(args->ws + WS_SSP); LAS float* RS = (LAS float*)((LAS unsigned char*)lds + RSTD_OFF);
            pg8::Unit u0; int pm_tab = -1;
            if (S.next(0, u0)) { pm_tab = u0.pm;
                if (tid < 256) { const float* sp = ssp + (size_t)(pm_tab * 256 + tid) * 32; float tot = 0.f;
#pragma unroll
                    for (int q = 0; q < 8; ++q) { const f32x4 p4 = *(const f32x4*)(sp + 4 * q); tot += (p4.x + p4.y) + (p4.z + p4.w); }
                    RS[tid] = 1.f / sqrtf(tot * (1.f / D_) + NORM_EPS); } }
            __syncthreads();
            EpiBf16Rs E{(bf16*)(args->ws + WS_PROJ), LDP, ssp, RS, pm_tab};
            pg8::gemm_phase<EpiBf16Rs, pg8::StaticOrder, (PATT == 11 ? 1 : (PATT == 12 ? 2 : 0))>((LAS unsigned char*)lds, g, S, E, tid);
        }
        if (IN(p0 + 1)) { SITE();
            constexpr int NU = (M_ / 256) * (LDP / 256); const int first_idle = NU % G;
            __syncthreads();
            if (l == 0 && bx >= first_idle) for (int g = bx - first_idle; g < 32; g += G - first_idle) s5_build_group(args, l, g, lds, tid);
        }
        SEAM(p0 + 1);
        if (IN(p0 + 2)) { { SITE(); phase_prep(args, l, gw, NGW, lane, args->rep == 0); } }
        SEAM(p0 + 2);
        if (IN(p0 + 3)) {
            { SITE();
              for (int ui = bx; ui < (M_ / 256) * 4; ui += G) { SITE();
                  pg8::Gemm g{(const bf16*)(args->ws + WS_WLA), (const bf16*)(args->ws + WS_LBT) + (size_t)l * 1024 * 256, M_, 1024, 256, 256, 256}; OneUnit S{ui >> 2, ui & 3};
                  EpiLora E{args, l, args->rep != 0};
                  pg8::gemm_phase<EpiLora, OneUnit>((LAS unsigned char*)lds, g, S, E, tid); __syncthreads(); }
              asm volatile("s_waitcnt vmcnt(0)" ::: "memory"); __syncthreads();
              if (xb_thread0(wave_s)) { __builtin_amdgcn_fence(__ATOMIC_RELEASE, "agent"); asm volatile("s_waitcnt vmcnt(0)" ::: "memory"); (void)xb_add(ctl + CW_Q + 64 * (l * 32 + 4 * args0.rep) + 16, 1u); } }
            { SITE(); unsigned* q1 = ctl + CW_Q + 64 * (l * 32 + 4 * args0.rep) + 64 * 0 + 32;
              for (;;) { const int u = q_pop(q1, MISC + 16, wave_s); if (u >= 128) break; { SITE(); s5_step_g1(args, lds, u, tid); } { SITE(); s5_step_scan(args, l, lds, u, tid); } { SITE(); s5_step_g2(args, l, lds, u, tid); } } }
            { SITE(); pg8::Gemm g{(const bf16*)(args->ws + WS_CQN), (const bf16*)(args->ws + WS_WUQ) + (size_t)l * NQ * 512, M_, NQ, 512, 512, 512}; pg8::StaticOrder S; S.init(M_, NQ, G, bx);
              EpiBf16 E{(bf16*)(args->ws + WS_QM), NQ}; pg8::gemm_phase<EpiBf16, pg8::StaticOrder>((LAS unsigned char*)lds, g, S, E, tid); }
            { SITE(); pg8::Gemm g{(const bf16*)(args->ws + WS_CKVN), (const bf16*)(args->ws + WS_WUKV) + (size_t)l * NKV * 256, M_, NKV, 256, 256, 256}; pg8::StaticOrder S; S.init(M_, NKV, G, bx);
              EpiBf16 E{(bf16*)(args->ws + WS_KVM), NKV}; pg8::gemm_phase<EpiBf16, pg8::StaticOrder>((LAS unsigned char*)lds, g, S, E, tid); }

            { SITE();
              unsigned* dn = ctl + CW_Q + 64 * (l * 32 + 4 * args0.rep) + 16;
              if (xb_thread0(wave_s)) { XB_SPIN(xb_ld(dn) < (unsigned)G, ctl + CW_BAR); __builtin_amdgcn_fence(__ATOMIC_ACQUIRE, "agent"); asm volatile("s_waitcnt vmcnt(0)" ::: "memory"); }
              __syncthreads(); }
            { SITE(); unsigned* qc = ctl + CW_Q + 64 * (l * 32 + 4 * args0.rep) + 64 * 2 + 32;
              QTicket qt1_ = q_first(qc, wave_s); int u = q_next(qt1_, qc, (unsigned)(B_ * 128 * 4), MISC + 16, wave_s); CkPre pre_; pre_.r = pre_.k = pre_.v = pre_.kk = pre_.al = pre_.ee = (v4u){0u, 0u, 0u, 0u}; if (u < B_ * 128 * 4) ck_prefetch(args, u, tid, pre_);
              while (u < B_ * 128 * 4) u = rwkv_chunk_unit(args, l, lds, u, tid, args->rep != 0, pre_, qt1_, qc, (unsigned)(B_ * 128 * 4), MISC + 16, wave_s); }
        }
        SEAM(p0 + 3);
        if (IN(p0 + 4)) {
            const int rep = args0.rep; unsigned* qh = ctl + CW_Q + 64 * (l * 32 + 4 * rep);
            if (rep == 0 || rep == 1 || rep == 4) { SITE(); QTicket qt2_ = q_first(qh + 0 * 64, wave_s); for (;;) { const int u = q_next(qt2_, qh + 0 * 64, (unsigned)(32), MISC + 16, wave_s); if (u >= 32) break; rwkv_scan_unit(args, lds, u, tid, rep != 0, qh + 48); } }
            for (int pass = 0; pass < 2; ++pass) {
            if (((bx + pass) & 1) == 0) {
            if (rep == 0 || rep == 2 || rep == 4) { SITE(); QTicket qt3_ = q_first(qh + 1 * 64, wave_s); for (;;) { const int u = q_next(qt3_, qh + 1 * 64, (unsigned)(256), MISC + 16, wave_s); if (u >= 256) break;
                attn_unit<0>(args, l, lds, (u & 15) >> 2, u & 3, 15 - (u >> 4), 0.f, 0.f, tid); } }
            } else {
            if (rep == 0 || rep == 3 || rep == 4) {   SITE(); const float* lq1 = (const float*)args->in[I_LQ1] + l * 64; const float* lk1 = (const float*)args->in[I_LK1] + l * 64;
                const float* lq2 = (const float*)args->in[I_LQ2] + l * 64; const float* lk2 = (const float*)args->in[I_LK2] + l * 64;
                const float lam_init = 0.8f - 0.6f * expf(-0.3f * (float)l);
                const float lam = expf(wave_sum_fast(lq1[lane] * lk1[lane])) - expf(wave_sum_fast(lq2[lane] * lk2[lane])) + lam_init;
                QTicket qt4_ = q_first(qh + 2 * 64, wave_s); for (;;) { const int u = q_next(qt4_, qh + 2 * 64, (unsigned)(512), MISC + 16, wave_s); if (u >= 512) break;
                    const int bb_ = (u & 15) >> 2, hh_ = u & 3, qb_ = 31 - (u >> 4);
                    attn_unit<1, PATT>(args, l, lds, bb_, hh_, qb_, lam, lam_init, tid); }
            }
            }
            }
            if (rep == 0 || rep == 4) {
                {   SITE();
                    unsigned* qg = qh + 3 * 64; QTicket qt5_ = q_first(qg, wave_s);
                    for (;;) { const int u = q_next(qt5_, qg, (unsigned)(128), MISC + 16, wave_s); if (u >= 128) break;
                        SITE(); pg8::Gemm g{(const bf16*)(args->ws + WS_GACT), (const bf16*)(args->ws + WS_WGLU) + (size_t)l * 512 * 512, M_, 512, 512, 512, 512}; OneUnit S{u >> 1, u & 1};
                        EpiGlu E{(const bf16*)(args->ws + WS_GACT), (const float*)args->in[I_S5BGLU] + l * 512, (const bf16*)(args->ws + WS_PROJ), (bf16*)(args->ws + WS_MIXED)};
                        pg8::gemm_phase<EpiGlu, OneUnit>((LAS unsigned char*)lds, g, S, E, tid); __syncthreads(); } }
                if (l + 1 < L_) { SITE();
                    unsigned* qb = qh + 64 + 32; QTicket qt7_ = q_first(qb, wave_s);
                    for (;;) { const int u = q_next(qt7_, qb, (unsigned)(32), MISC + 16, wave_s); if (u >= 32) break; s5_build_group(args, l + 1, u, lds, tid); } }
                {   SITE();
                    unsigned* dn = qh + 48;
                    if (xb_thread0(wave_s)) { XB_SPIN(xb_ld(dn) < 32u, ctl + CW_BAR); __builtin_amdgcn_fence(__ATOMIC_ACQUIRE, "agent"); asm volatile("s_waitcnt vmcnt(0)" ::: "memory"); }
                    __syncthreads();
                    unsigned* qf = qh + 3 * 64 + 32; QTicket qt6_ = q_first(qf, wave_s);
                    for (;;) { const int u = q_next(qt6_, qf, (unsigned)(M_ / 64), MISC + 16, wave_s); if (u >= M_ / 64) break; phase_rwkv_finish(args, l, u * 64, u * 64 + 64, wave, lane); } }
            }
        }
        SEAM(p0 + 4);
        if (IN(p0 + 5)) { SITE();
            pg8::Gemm g{(const bf16*)(args->ws + WS_MIXED), (const bf16*)(args->ws + WS_WOUT) + (size_t)l * D_ * D_, M_, D_, D_, D_, D_}; pg8::StaticOrder S; S.init(M_, D_, G, bx);
            const bf16* xl = (const bf16*)args->out + (size_t)(l & 1) * M_ * D_; bf16* xn = (bf16*)args->out + (size_t)((l + 1) & 1) * M_ * D_;
            EpiResidX E{(l == 0) ? (const float*)args->in[I_X] : nullptr, xl, xn, (l == L_ - 1) ? (float*)(args->ws + WS_PROJ) : nullptr, (float*)(args->ws + WS_SSP)};
            if (args->rep) { E.xout_b = (bf16*)(args->ws + WS_PROJ + 128 * MiB); E.xout_f = nullptr; E.ssn = (float*)(args->ws + WS_CKVN); }
            pg8::gemm_phase<EpiResidX, pg8::StaticOrder>((LAS unsigned char*)lds, g, S, E, tid);
        }
        SEAM(p0 + 5);
    }
    if (IN(N_PHASES - 1)) { SITE(); phase_rmsnorm<true>((const float*)(args->ws + WS_PROJ), (const float*)args->in[I_FNG], args->out, gw, NGW, lane); }
#undef IN
#undef SEAM
}

__global__ void __launch_bounds__(NTHR, 2) fwd(Args args0) { fwd_body<0>(args0); }
#if defined(PROBE_ATT)
__global__ void __launch_bounds__(NTHR, 2) fwd_probe(Args args0) { fwd_body<PROBE_ATT>(args0); }
#endif
#ifndef MK_ONE_LAUNCH
#define MK_ONE_LAUNCH 1
#endif
extern "C" void kernel_launch(void* const* d_in, const int* in_sizes, int n_in, void* d_out, int out_size, void* d_ws, size_t ws_size, hipStream_t stream) {
    static int grid = 0;
    if (grid == 0) {
        if (n_in != N_INPUTS || out_size != M_ * D_ || ws_size < WS_END2) { fprintf(stderr, "kernel_launch: unexpected shapes (n_in %d, out %d, ws %zu < %zu)\n", n_in, out_size, ws_size, (size_t)WS_END); grid = -1; return; }
        int dev = 0, cus = 0, per_cu = 0;
        if (hipGetDevice(&dev) != hipSuccess || hipDeviceGetAttribute(&cus, hipDeviceAttributeMultiprocessorCount, dev) != hipSuccess) { grid = -1; return; }
#if defined(PROBE_ATT)
        (void)hipFuncSetAttribute((const void*)fwd_probe, hipFuncAttributeMaxDynamicSharedMemorySize, LDS_BYTES);
#endif
        if (hipFuncSetAttribute((const void*)fwd, hipFuncAttributeMaxDynamicSharedMemorySize, LDS_BYTES) != hipSuccess) { fprintf(stderr, "kernel_launch: hipFuncSetAttribute failed\n"); grid = -1; return; }
        if (hipOccupancyMaxActiveBlocksPerMultiprocessor(&per_cu, (const void*)fwd, NTHR, LDS_BYTES) != hipSuccess || per_cu < 1) { fprintf(stderr, "kernel_launch: occupancy query says %d\n", per_cu); }
        (void)hipGetLastError();
        grid = cus;
    }
    if (grid < 0) return;
    (void)hipMemsetAsync((char*)d_ws + WS_CTL, 0, CTL_ZERO_BYTES, stream);
    Args a{};
    for (int i = 0; i < N_INPUTS; ++i) a.in[i] = d_in[i];
    a.out = (float*)d_out; a.ws = (unsigned char*)d_ws;
#if defined(PROBE_K)
#define PROBE_THIS(p) ((PROBE_K == 100) ? ((p) == 0) : (PROBE_K == 101) ? ((p) == N_PHASES - 1) : ((p) >= 1 && (p) < N_PHASES - 1 && ((p) - 1) % PH_PER_L == PROBE_K))
    for (int p = 0; p < N_PHASES; ++p) { a.ph_lo = p; a.ph_hi = p + 1;
#if defined(PROBE_BEFORE)
        if (PROBE_THIS(p)) for (int r = 1; r <= PROBE_N; ++r) { a.rep = PROBE_REP;
#if defined(PROBE_ATT)
            hipLaunchKernelGGL(fwd_probe, dim3(grid), dim3(NTHR), LDS_BYTES, stream, a);
#else
            hipLaunchKernelGGL(fwd, dim3(grid), dim3(NTHR), LDS_BYTES, stream, a);
#endif
        }
#endif
        a.rep = 0; hipLaunchKernelGGL(fwd, dim3(grid), dim3(NTHR), LDS_BYTES, stream, a);
#if !defined(PROBE_BEFORE)
        if (PROBE_THIS(p)) for (int r = 1; r <= PROBE_N; ++r) { a.rep = PROBE_REP; hipLaunchKernelGGL(fwd, dim3(grid), dim3(NTHR), LDS_BYTES, stream, a); }
#endif
    }
#elif MK_ONE_LAUNCH
    a.ph_lo = 0; a.ph_hi = N_PHASES;
    hipLaunchKernelGGL(fwd, dim3(grid), dim3(NTHR), LDS_BYTES, stream, a);
#else
    for (int p = 0; p < N_PHASES; ++p) { a.ph_lo = p; a.ph_hi = p + 1; hipLaunchKernelGGL(fwd, dim3(grid), dim3(NTHR), LDS_BYTES, stream, a); }
#endif
}
```
